# Optimizing an MI355X kernel written in HIP

```python
import math
import jax, jax.numpy as jnp
from jax import lax
import numpy as np


D_MODEL = 1024
BATCH = 32
SEQ = 2048
DEPTH = 1

ATT_GROUPS = ((128, 1), (512, 4), (2048, 16))
N_ATT_GROUPS = 3
ATT_HEADS_PER_GROUP = 4
ATT_HEAD_DIM = 128
N_ATT_HEADS = N_ATT_GROUPS * ATT_HEADS_PER_GROUP
ATT_GROUP_WIDTH = ATT_HEADS_PER_GROUP * ATT_HEAD_DIM
ATT_BLOCK = 128
ML_HEADS = 8
ML_QK_DIM = 64
ML_V_DIM = 128
ML_QK_WIDTH = ML_HEADS * ML_QK_DIM
ML_V_WIDTH = ML_HEADS * ML_V_DIM
ML_CHUNK = 64
CONV_WIDTH = 4
D_FF = 4 * D_MODEL
N_BUCKETS = 32
MAX_DISTANCE = 2048
N_BRANCHES = 2
EPS = 1e-6

IN_SPLITS = (
    N_ATT_GROUPS * ATT_GROUP_WIDTH,
    N_ATT_GROUPS * ATT_GROUP_WIDTH,
    N_ATT_GROUPS * ATT_GROUP_WIDTH,
    ML_QK_WIDTH,
    ML_QK_WIDTH,
    ML_V_WIDTH,
    ML_V_WIDTH,
    ML_HEADS,
    ML_HEADS,
    N_BRANCHES * D_MODEL,
)
D_IN = sum(IN_SPLITS)

kernel_name = 'hybrid_dilated_attn_mlstm_block'


def _rms_norm(x, gain):
    x32 = x.astype(jnp.float32)
    y = x32 * lax.rsqrt(jnp.mean(x32 * x32, axis=-1, keepdims=True) + EPS)
    return (y * gain.astype(jnp.float32)).astype(x.dtype)


def _t5_bucket(dist):
    max_exact = N_BUCKETS // 2
    d = jnp.maximum(dist, max_exact).astype(jnp.float32)
    large = max_exact + (jnp.log(d / max_exact) / math.log(MAX_DISTANCE / max_exact)
                         * (N_BUCKETS - max_exact)).astype(jnp.int32)
    large = jnp.minimum(large, N_BUCKETS - 1)
    return jnp.where(dist < max_exact, dist, large)


def _causal_conv(x, w, b):
    S = x.shape[1]
    xp = jnp.pad(x, ((0, 0), (CONV_WIDTH - 1, 0), (0, 0)))
    y = b
    for j in range(CONV_WIDTH):
        y = y + w[j] * xp[:, j:j + S]
    return y


def _dilated_attention(q, k, v, bias_table, window, dilation):
    B, S, H, dh = q.shape
    n_look = window // dilation
    n_sub = S // dilation
    nb = -(-n_sub // ATT_BLOCK)
    n_pad = nb * ATT_BLOCK

    def to_blocks(t):
        t = t.reshape(B, n_sub, dilation, H, dh).transpose(0, 2, 3, 1, 4)
        t = jnp.pad(t, ((0, 0), (0, 0), (0, 0), (0, n_pad - n_sub), (0, 0)))
        return t.astype(jnp.float32).reshape(B, dilation, H, nb, ATT_BLOCK, dh)

    def with_prev(t):
        prev = jnp.pad(t, ((0, 0), (0, 0), (0, 0), (1, 0), (0, 0), (0, 0)))[:, :, :, :-1]
        return jnp.concatenate([prev, t], axis=4)

    qb = to_blocks(q)
    kb = with_prev(to_blocks(k))
    vb = with_prev(to_blocks(v))

    i = jnp.arange(ATT_BLOCK)[:, None]
    j = jnp.arange(2 * ATT_BLOCK)[None, :]
    delta = ATT_BLOCK + i - j
    key_idx = jnp.arange(nb)[:, None, None] * ATT_BLOCK - ATT_BLOCK + j
    valid = (delta >= 0) & (delta <= n_look) & (key_idx >= 0)
    bucket = _t5_bucket(jnp.maximum(delta, 0) * dilation)
    bias = bias_table[bucket].astype(jnp.float32).transpose(2, 0, 1)

    s = jnp.einsum('brhnqd,brhnkd->brhnqk', qb, kb) * (dh ** -0.5) + bias[None, None, :, None]
    s = jnp.where(valid[None, None, None], s, -jnp.inf)
    m = jnp.max(s, axis=-1, keepdims=True)
    p = jnp.exp(s - m)
    l = jnp.sum(p, axis=-1, keepdims=True)
    o = jnp.einsum('brhnqk,brhnkd->brhnqd', p, vb) / l
    lse = (m + jnp.log(l))[..., 0]

    o = o.reshape(B, dilation, H, n_pad, dh)[:, :, :, :n_sub]
    o = o.transpose(0, 3, 1, 2, 4).reshape(B, S, H, dh)
    lse = lse.reshape(B, dilation, H, n_pad)[..., :n_sub]
    lse = lse.transpose(0, 3, 1, 2).reshape(B, S, H)
    return o, lse


def _mlstm_chunkwise(q, k, v, log_i, log_f):
    B, S, H, dk = q.shape
    dv = v.shape[-1]
    L = ML_CHUNK
    nc = S // L

    def chunks(t):
        rest = t.shape[3:]
        t = t.reshape((B, nc, L, H) + rest)
        return t.transpose((1, 0, 3, 2) + tuple(range(4, t.ndim)))

    causal = jnp.tril(jnp.ones((L, L), dtype=bool))

    def step(carry, xs):
        C, n, m = carry
        qc, kc, vc, li, lf = xs
        b = jnp.cumsum(lf, axis=-1)
        a = b + m[..., None]
        Dm = b[..., :, None] - b[..., None, :] + li[..., None, :]
        Dm = jnp.where(causal, Dm, -jnp.inf)
        m_t = jnp.maximum(a, jnp.max(Dm, axis=-1))
        w = jnp.einsum('bhtd,bhsd->bhts', qc, kc) * jnp.exp(Dm - m_t[..., None])
        inter = jnp.exp(a - m_t)
        num = jnp.einsum('bhts,bhsv->bhtv', w, vc) + inter[..., None] * jnp.einsum('bhtd,bhdv->bhtv', qc, C)
        nq = jnp.sum(w, axis=-1) + inter * jnp.einsum('bhtd,bhd->bht', qc, n)
        h = num / jnp.maximum(jnp.abs(nq), jnp.exp(-m_t))[..., None]
        b_end = b[..., -1]
        g = b_end[..., None] - b + li
        m_new = jnp.maximum(b_end + m, jnp.max(g, axis=-1))
        decay = jnp.exp(b_end + m - m_new)
        wk = jnp.exp(g - m_new[..., None])
        C = decay[..., None, None] * C + jnp.einsum('bhs,bhsd,bhsv->bhdv', wk, kc, vc)
        n = decay[..., None] * n + jnp.einsum('bhs,bhsd->bhd', wk, kc)
        return (C, n, m_new), h

    init = (jnp.zeros((B, H, dk, dv), jnp.float32),
            jnp.zeros((B, H, dk), jnp.float32),
            jnp.zeros((B, H), jnp.float32))
    _, h = lax.scan(step, init, (chunks(q), chunks(k), chunks(v), chunks(log_i), chunks(log_f)))
    return h.transpose(1, 0, 3, 2, 4).reshape(B, S, H, dv)


def setup_inputs(seed: int = 0) -> dict:
    key = jax.random.key(seed)
    ks = jax.random.split(key, 20)
    f32 = jnp.float32

    def w(k, shape, fan_in, gain=1.0):
        return jax.random.normal(k, shape, f32) * (gain * fan_in ** -0.5)

    def gain_vec(k, shape):
        return 1.0 + 0.02 * jax.random.normal(k, shape, f32)

    gate_bias_offset = jnp.stack([jnp.zeros((ML_HEADS,), f32),
                                  jnp.linspace(3.0, 6.0, ML_HEADS, dtype=f32)])
    return {
        'x': jax.random.normal(ks[0], (BATCH, SEQ, D_MODEL), f32),
        'c': jax.random.normal(ks[1], (BATCH, D_MODEL), f32),
        'w_ada': w(ks[2], (DEPTH, D_MODEL, 6 * D_MODEL), D_MODEL, 0.5),
        'b_ada': 0.02 * jax.random.normal(ks[3], (DEPTH, 6 * D_MODEL), f32),
        'norm1_g': gain_vec(ks[4], (DEPTH, D_MODEL)),
        'norm2_g': gain_vec(ks[5], (DEPTH, D_MODEL)),
        'w_in': w(ks[6], (DEPTH, D_MODEL, D_IN), D_MODEL),
        'b_if': gate_bias_offset + 0.1 * jax.random.normal(ks[7], (DEPTH, 2, ML_HEADS), f32),
        'conv_w': w(ks[8], (DEPTH, CONV_WIDTH, 2 * ML_QK_WIDTH), CONV_WIDTH),
        'conv_b': 0.02 * jax.random.normal(ks[9], (DEPTH, 2 * ML_QK_WIDTH), f32),
        'q_norm_g': gain_vec(ks[10], (DEPTH, ATT_HEAD_DIM)),
        'k_norm_g': gain_vec(ks[11], (DEPTH, ATT_HEAD_DIM)),
        'rel_bias': 0.5 * jax.random.normal(ks[12], (N_BUCKETS, N_ATT_HEADS), f32),
        'mlstm_norm_g': gain_vec(ks[13], (DEPTH, ML_V_WIDTH)),
        'w_att_out': w(ks[14], (DEPTH, ATT_GROUP_WIDTH, D_MODEL), ATT_GROUP_WIDTH),
        'w_ml_out': w(ks[15], (DEPTH, ML_V_WIDTH, D_MODEL), ML_V_WIDTH),
        'w_out': w(ks[16], (DEPTH, D_MODEL, D_MODEL), D_MODEL),
        'w_ff1': w(ks[17], (DEPTH, D_MODEL, D_FF), D_MODEL),
        'w_ff2': w(ks[18], (DEPTH, D_FF, D_MODEL), D_FF),
    }


def reference(x, c, w_ada, b_ada, norm1_g, norm2_g, w_in, b_if, conv_w, conv_b,
              q_norm_g, k_norm_g, rel_bias, mlstm_norm_g, w_att_out, w_ml_out,
              w_out, w_ff1, w_ff2):
    B, S, _ = x.shape
    split_points = [int(p) for p in np.cumsum(IN_SPLITS)[:-1]]
    for l in range(DEPTH):
        ada = jax.nn.silu(c) @ w_ada[l] + b_ada[l]
        shift1, scale1, gate1, shift2, scale2, gate2 = [t[:, None, :] for t in jnp.split(ada, 6, axis=-1)]

        u = _rms_norm(x, norm1_g[l]) * (1 + scale1) + shift1
        proj = u @ w_in[l]
        aq, ak, av, mq, mk, mv, mo, mi, mf, gates = jnp.split(proj, split_points, axis=-1)

        aq = _rms_norm(aq.reshape(B, S, N_ATT_HEADS, ATT_HEAD_DIM), q_norm_g[l])
        ak = _rms_norm(ak.reshape(B, S, N_ATT_HEADS, ATT_HEAD_DIM), k_norm_g[l])
        av = av.reshape(B, S, N_ATT_HEADS, ATT_HEAD_DIM)
        outs, lses = [], []
        for g, (window, dilation) in enumerate(ATT_GROUPS):
            sl = slice(g * ATT_HEADS_PER_GROUP, (g + 1) * ATT_HEADS_PER_GROUP)
            o, lse = _dilated_attention(aq[:, :, sl], ak[:, :, sl], av[:, :, sl],
                                        rel_bias[:, sl], window, dilation)
            outs.append(o)
            lses.append(lse)
        wts = jax.nn.softmax(jnp.stack(lses, axis=0), axis=0)
        att = jnp.sum(wts[..., None] * jnp.stack(outs, axis=0), axis=0)
        y_att = att.reshape(B, S, ATT_GROUP_WIDTH).astype(x.dtype) @ w_att_out[l]

        qk = jax.nn.silu(_causal_conv(jnp.concatenate([mq, mk], axis=-1), conv_w[l], conv_b[l]))
        mq, mk = jnp.split(qk.astype(jnp.float32), 2, axis=-1)
        mq = mq.reshape(B, S, ML_HEADS, ML_QK_DIM)
        mk = mk.reshape(B, S, ML_HEADS, ML_QK_DIM) * (ML_QK_DIM ** -0.5)
        mv = mv.astype(jnp.float32).reshape(B, S, ML_HEADS, ML_V_DIM)
        log_i = mi.astype(jnp.float32) + b_if[l, 0].astype(jnp.float32)
        log_f = jax.nn.log_sigmoid(mf.astype(jnp.float32) + b_if[l, 1].astype(jnp.float32))
        h = _mlstm_chunkwise(mq, mk, mv, log_i, log_f)
        h = _rms_norm(h, mlstm_norm_g[l].reshape(ML_HEADS, ML_V_DIM)).reshape(B, S, ML_V_WIDTH)
        h = h * jax.nn.sigmoid(mo.astype(jnp.float32))
        y_ml = h.astype(x.dtype) @ w_ml_out[l]

        g_att, g_ml = jnp.split(jax.nn.sigmoid(gates), N_BRANCHES, axis=-1)
        y = (g_att * y_att + g_ml * y_ml) @ w_out[l]
        x = x + gate1 * y

        u2 = _rms_norm(x, norm2_g[l]) * (1 + scale2) + shift2
        hdn = jnp.square(jax.nn.relu(u2 @ w_ff1[l]))
        x = x + gate2 * (hdn @ w_ff2[l])
    return x
```

```cpp
#include <hip/hip_runtime.h>
#include <hip/hip_cooperative_groups.h>
#include <cstdio>
#include <cstdint>
namespace cg = cooperative_groups;
namespace pg8 {
#define PG8_LAS __attribute__((address_space(3)))
typedef unsigned short bf16_t;
typedef short bf16x8 __attribute__((ext_vector_type(8)));
typedef float f32x4 __attribute__((ext_vector_type(4)));
typedef unsigned u32x4 __attribute__((ext_vector_type(4)));
constexpr int BM = 256, BK = 64, HALF = 128, HTB = HALF * BK * 2  , STAGE_BYTES = 8 * HTB, NXCD = 8, WGM = 8;

__host__ __device__ __forceinline__ int lds_byte(int r, int c) { const int st = (r >> 4) * 2 + (c >> 5), rr = r & 15, cc = c & 31, ob = rr * 64 + cc * 2; return st * 1024 + (ob ^ (((ob >> 9) & 1) << 5)); }
__host__ __device__ __forceinline__ void stage_rc(int b, int& R, int& C) { const int st = b / 1024, sb = b % 1024, swz = sb ^ (((sb >> 9) & 1) << 5); R = (st >> 1) * 16 + swz / 64; C = (st & 1) * 32 + (swz % 64) / 2; }
__host__ __device__ __forceinline__ int perm32(int rho) { const int n = rho >> 4, i = rho & 15; return 8 * (i >> 2) + 4 * n + (i & 3); }

struct Unit { int pm, pn; };
struct Gemm { const bf16_t* A; const bf16_t* Bt; int M, N, K; };

struct StaticOrder {
    int nM, nN, nwg, G, c;
    __host__ __device__ void init(int M, int N, int G_, int c_) { nM = M / BM; nN = N / BM; nwg = nM * nN; G = G_; c = c_; }
    __host__ __device__ bool next(int i, Unit& u) const {
        const long L = (long)i * G + c; if (L >= nwg) return false;
        int wgid = (int)L; { const int q = nwg / NXCD, r = nwg % NXCD, xcd = wgid % NXCD, off = wgid / NXCD; wgid = (xcd < r ? xcd * (q + 1) : r * (q + 1) + (xcd - r) * q) + off; }
        const int nig = WGM * nN, gid = wgid / nig, fm = gid * WGM, gsz = (nM - fm) < WGM ? (nM - fm) : WGM;
        u.pm = fm + ((wgid % nig) % gsz); u.pn = (wgid % nig) / gsz; return true;
    }
    __device__ __forceinline__ void a_ready(const Unit&) const {}
    __device__ __forceinline__ void done(const Unit&) const {}
};

__device__ __forceinline__ unsigned cvt_pk_bf16(float lo, float hi) { unsigned r; asm volatile("v_cvt_pk_bf16_f32 %0, %1, %2" : "=v"(r) : "v"(lo), "v"(hi)); return r; }
typedef float f32x2 __attribute__((ext_vector_type(2)));
template <class Epi, class Sched, bool ALIGN_EPI = false, bool SP2 = false>
__device__ __forceinline__ void gemm_phase(PG8_LAS unsigned char* lds, const Gemm g, const Sched& S, const Epi& E) {
    int tid_ = threadIdx.x; asm volatile("" : "+v"(tid_));
    const int tid = tid_, wid = __builtin_amdgcn_readfirstlane(tid >> 6), lane = tid & 63, wr = wid >> 2, wc = wid & 3, fr = lane & 15, fq = lane >> 4;
    const int K = g.K, nt = K / BK;
    unsigned voffA[2], voffB[2];
#pragma unroll
    for (int i = 0; i < 2; ++i) { int R, C; stage_rc(tid * 16 + i * 8192, R, C); const int Rb = Epi::PERM ? ((R & ~31) + perm32(R & 31)) : R;
        voffA[i] = (unsigned)(R * K + C) * 2u; voffB[i] = (unsigned)(Rb * K + C) * 2u; }
    const size_t kstep = (size_t)(BK * 2);
    const size_t hstep = (size_t)HALF * K * 2;
    const size_t tstep = 2 * hstep;
    const unsigned ldsw = (unsigned)wid * 1024u;
    const int aoff = lds_byte(wr * 64 + fr, fq * 8), boff = lds_byte(wc * 32 + fr, fq * 8);
#define PG8_SA(b, h) (((b) * 2 + (h)) * HTB)
#define PG8_SB(b, h) ((4 + (b) * 2 + (h)) * HTB)
#define PG8_STAGE(bufoff, gbase, voff) do { _Pragma("unroll") for (int _i = 0; _i < 2; ++_i) \
        __builtin_amdgcn_global_load_lds((const unsigned*)((const char*)(gbase) + (voff)[_i]), (PG8_LAS unsigned*)(lds + (bufoff) + ldsw + _i * 8192), 16, 0, 0); } while (0)
#define PG8_LDA(dst, b, h) do { _Pragma("unroll") for (int m = 0; m < 4; ++m) _Pragma("unroll") for (int k = 0; k < 2; ++k) dst[m][k] = *(const PG8_LAS bf16x8*)(lds + PG8_SA(b, h) + aoff + m * 2048 + k * 1024); } while (0)
#define PG8_LDB(dst, b, h) do { _Pragma("unroll") for (int n = 0; n < 2; ++n) _Pragma("unroll") for (int k = 0; k < 2; ++k) dst[n][k] = *(const PG8_LAS bf16x8*)(lds + PG8_SB(b, h) + boff + n * 2048 + k * 1024); } while (0)
#define PG8_MMA(ai, bj, At, Bt) do { __builtin_amdgcn_s_setprio(1); _Pragma("unroll") for (int m = 0; m < 4; ++m) _Pragma("unroll") for (int n = 0; n < 2; ++n) _Pragma("unroll") for (int k = 0; k < 2; ++k) \
        acc[ai][bj][m][n] = __builtin_amdgcn_mfma_f32_16x16x32_bf16(Bt[n][k], At[m][k], acc[ai][bj][m][n], 0, 0, 0); __builtin_amdgcn_s_setprio(0); } while (0)
#define PG8_WAIT_V(n) asm volatile("s_waitcnt vmcnt(" #n ")" ::: "memory")
#define PG8_WAIT_L(n) asm volatile("s_waitcnt lgkmcnt(" #n ")" ::: "memory")
#define PG8_BAR __builtin_amdgcn_s_barrier()
#define PG8_SCHED __builtin_amdgcn_sched_barrier(0)
    Unit cur, nxt; int ui = 0;
    if (!S.next(0, cur)) return;
    f32x4 acc[2][2][4][2];
#pragma unroll
    for (int a = 0; a < 2; ++a)
#pragma unroll
        for (int b = 0; b < 2; ++b)
#pragma unroll
            for (int m = 0; m < 4; ++m)
#pragma unroll
                for (int n = 0; n < 2; ++n) acc[a][b][m][n] = (f32x4){0.f, 0.f, 0.f, 0.f};
    bf16x8 At[4][2], B0[2][2], B1[2][2];
    const char* cA = (const char*)g.A + (size_t)cur.pm * tstep; const char* cB = (const char*)g.Bt + (size_t)cur.pn * tstep;
    S.a_ready(cur);
    if constexpr (SP2) {
        PG8_STAGE(PG8_SB(0, 0), cB, voffB); PG8_STAGE(PG8_SB(0, 1), cB + hstep, voffB); PG8_STAGE(PG8_SA(0, 0), cA, voffA); PG8_STAGE(PG8_SA(0, 1), cA + hstep, voffA);
        if (wr == 1) PG8_BAR;
        PG8_WAIT_V(2); PG8_BAR;
        PG8_STAGE(PG8_SB(1, 0), cB + kstep, voffB); PG8_STAGE(PG8_SA(1, 0), cA + kstep, voffA); PG8_STAGE(PG8_SB(1, 1), cB + hstep + kstep, voffB);
        PG8_WAIT_V(6); PG8_BAR;
    } else {
        PG8_STAGE(PG8_SB(0, 0), cB, voffB); PG8_STAGE(PG8_SA(0, 0), cA, voffA); PG8_STAGE(PG8_SB(0, 1), cB + hstep, voffB); PG8_STAGE(PG8_SA(0, 1), cA + hstep, voffA);
        if (wr == 1) PG8_BAR;
        PG8_WAIT_V(4); PG8_BAR;
        PG8_STAGE(PG8_SB(1, 0), cB + kstep, voffB); PG8_STAGE(PG8_SA(1, 0), cA + kstep, voffA); PG8_STAGE(PG8_SB(1, 1), cB + hstep + kstep, voffB);
        PG8_WAIT_V(6); PG8_BAR;
    }
    for (;;) {
        const bool has_next = S.next(ui + 1, nxt);
        const char* nA = has_next ? (const char*)g.A + (size_t)nxt.pm * tstep : cA; const char* nB = has_next ? (const char*)g.Bt + (size_t)nxt.pn * tstep : cB;
        for (int t = 0; t < nt; t += 2) {
            const bool last = (t == nt - 2);
            const char* a1 = cA + (size_t)(t + 1) * kstep;
            const char* a2 = last ? nA : cA + (size_t)(t + 2) * kstep; const char* b2 = last ? nB : cB + (size_t)(t + 2) * kstep;
            const char* a3 = a2 + kstep; const char* b3 = b2 + kstep;
            if (last && has_next) S.a_ready(nxt);
            if constexpr (SP2) {
            PG8_LDB(B0, 0, 0); PG8_LDB(B1, 0, 1); PG8_SCHED; PG8_LDA(At, 0, 0); PG8_STAGE(PG8_SA(1, 1), a1 + hstep, voffA);
            PG8_WAIT_V(8); PG8_WAIT_L(0); PG8_BAR; PG8_MMA(0, 0, At, B0); PG8_MMA(0, 1, At, B1); PG8_BAR; PG8_SCHED;
            PG8_LDA(At, 0, 1); PG8_STAGE(PG8_SB(0, 0), b2, voffB); PG8_STAGE(PG8_SB(0, 1), b2 + hstep, voffB); PG8_STAGE(PG8_SA(0, 0), a2, voffA);
            PG8_WAIT_V(8); PG8_WAIT_L(0); PG8_BAR; PG8_MMA(1, 0, At, B0); PG8_MMA(1, 1, At, B1); PG8_BAR; PG8_SCHED;
            PG8_LDB(B0, 1, 0); PG8_LDB(B1, 1, 1); PG8_SCHED; PG8_LDA(At, 1, 0); PG8_STAGE(PG8_SA(0, 1), a2 + hstep, voffA);
            PG8_WAIT_V(8); PG8_WAIT_L(0); PG8_BAR; PG8_MMA(0, 0, At, B0); PG8_MMA(0, 1, At, B1); PG8_BAR; PG8_SCHED;
            PG8_LDA(At, 1, 1); PG8_STAGE(PG8_SB(1, 0), b3, voffB); PG8_STAGE(PG8_SB(1, 1), b3 + hstep, voffB); PG8_STAGE(PG8_SA(1, 0), a3, voffA);
            PG8_WAIT_V(8); PG8_WAIT_L(0); PG8_BAR; PG8_MMA(1, 0, At, B0); PG8_MMA(1, 1, At, B1); PG8_BAR; PG8_SCHED;
            } else {
            PG8_LDB(B0, 0, 0); PG8_SCHED; PG8_LDA(At, 0, 0); PG8_STAGE(PG8_SA(1, 1), a1 + hstep, voffA);
            PG8_WAIT_L(8); PG8_BAR; PG8_WAIT_L(0); PG8_MMA(0, 0, At, B0); PG8_BAR; PG8_SCHED;
            PG8_LDB(B1, 0, 1); PG8_STAGE(PG8_SB(0, 0), b2, voffB);
            PG8_BAR; PG8_WAIT_L(0); PG8_MMA(0, 1, At, B1); PG8_BAR;
            PG8_LDA(At, 0, 1); PG8_STAGE(PG8_SA(0, 0), a2, voffA);
            PG8_BAR; PG8_WAIT_L(0); PG8_MMA(1, 0, At, B0); PG8_BAR; PG8_SCHED;
            PG8_STAGE(PG8_SB(0, 1), b2 + hstep, voffB);
            PG8_WAIT_V(6); PG8_BAR; PG8_MMA(1, 1, At, B1); PG8_BAR;
            PG8_LDB(B0, 1, 0); PG8_SCHED; PG8_LDA(At, 1, 0); PG8_STAGE(PG8_SA(0, 1), a2 + hstep, voffA);
            PG8_WAIT_L(8); PG8_BAR; PG8_WAIT_L(0); PG8_MMA(0, 0, At, B0); PG8_BAR; PG8_SCHED;
            PG8_LDB(B1, 1, 1); PG8_STAGE(PG8_SB(1, 0), b3, voffB);
            PG8_BAR; PG8_WAIT_L(0); PG8_MMA(0, 1, At, B1); PG8_BAR;
            PG8_LDA(At, 1, 1); PG8_STAGE(PG8_SA(1, 0), a3, voffA);
            PG8_BAR; PG8_WAIT_L(0); PG8_MMA(1, 0, At, B0); PG8_BAR; PG8_SCHED;
            PG8_STAGE(PG8_SB(1, 1), b3 + hstep, voffB);
            PG8_WAIT_V(6); PG8_BAR; PG8_MMA(1, 1, At, B1); PG8_BAR;
            }
        }
        if constexpr (ALIGN_EPI) { if (wr == 0) PG8_BAR; }
        if constexpr (!Epi::AFTER_DRAIN) { E(acc, cur, wr, wc, fr, fq); S.done(cur); }
        if (!has_next) break;
#pragma unroll
        for (int a = 0; a < 2; ++a)
#pragma unroll
            for (int b = 0; b < 2; ++b)
#pragma unroll
                for (int m = 0; m < 4; ++m)
#pragma unroll
                    for (int n = 0; n < 2; ++n) acc[a][b][m][n] = (f32x4){0.f, 0.f, 0.f, 0.f};
        cur = nxt; cA = nA; cB = nB; ++ui;
        if constexpr (ALIGN_EPI) { if (wr == 1) PG8_BAR; }
    }
    PG8_WAIT_V(0);
    if constexpr (!ALIGN_EPI) { if (wr == 0) PG8_BAR; }
    PG8_BAR;
    if constexpr (Epi::AFTER_DRAIN) { E.fused(acc, cur, wr, wc, fr, fq, lds, wid, lane); S.done(cur); }
#undef PG8_SA
#undef PG8_SB
#undef PG8_STAGE
#undef PG8_LDA
#undef PG8_LDB
#undef PG8_MMA
#undef PG8_WAIT_V
#undef PG8_WAIT_L
#undef PG8_BAR
#undef PG8_SCHED
}
}

#define LAS __attribute__((address_space(3)))
#define DI __device__ __forceinline__
typedef unsigned short bf16;
typedef unsigned v4u __attribute__((ext_vector_type(4)));
typedef unsigned v2u __attribute__((ext_vector_type(2)));
typedef float f32x4 __attribute__((ext_vector_type(4)));
typedef float f32x16 __attribute__((ext_vector_type(16)));
typedef short bf16x8 __attribute__((ext_vector_type(8)));
typedef short v4i16_t __attribute__((ext_vector_type(4)));
#define MFMA32(a, b, c) __builtin_amdgcn_mfma_f32_32x32x16_bf16((a), (b), (c), 0, 0, 0)
#define LDS_WAIT() asm volatile("s_waitcnt lgkmcnt(0)" ::: "memory")

constexpr int T_ALL = 65536, DM = 1024, SEQ = 2048, TH = 32768, PP = 9728, NPAD = 9984, DIN = 9744;
constexpr size_t MiB = 1u << 20;
constexpr size_t WS_ADA = 0, WS_CTL = 0xC0000, WS_ROWSS = 0x100000, WS_BIAS2 = 0x140000, WS_ZERO_BYTES = 0x1C0000;
constexpr size_t WS_WIN = 2 * MiB, WS_WATT = 22 * MiB, WS_WML = 23 * MiB, WS_WOUT = 25 * MiB, WS_WFF1 = 27 * MiB, WS_WFF2 = 35 * MiB;
constexpr size_t WS_IF = 44 * MiB, WS_U = 48 * MiB, WS_P = 176 * MiB, WS_HID = 176 * MiB, WS_OG = 784 * MiB, WS_YPRE = 784 * MiB;
constexpr size_t WS_LSE = 880 * MiB, WS_H = 882 * MiB, WS_ATT = 946 * MiB, WS_END = 978 * MiB;
constexpr int LDS_BYTES = 147456;

DI size_t pidx(size_t row, int col) { return (size_t)(col >> 8) * ((size_t)TH * 256) + row * 256 + (size_t)(col & 255); }
DI float lo_f(unsigned u) { return __uint_as_float(u << 16); }
DI float hi_f(unsigned u) { return __uint_as_float(u & 0xffff0000u); }
DI float bf2f(unsigned short b) { return __uint_as_float((unsigned)b << 16); }
DI unsigned pk2(float lo, float hi) { return pg8::cvt_pk_bf16(lo, hi); }
DI int crow(int r, int h) { return (r & 3) + 8 * (r >> 2) + 4 * h; }
DI float sigmoidf_(float v) { return __builtin_amdgcn_rcpf(1.0f + __expf(-v)); }
DI float wave_sum(float v) {
#pragma unroll
    for (int o = 1; o < 64; o <<= 1) v += __shfl_xor(v, o);
    return v;
}
DI bf16x8 tr8(LAS unsigned char* plo, LAS unsigned char* phi) {
    v4i16_t a = __builtin_amdgcn_ds_read_tr16_b64_v4i16((LAS v4i16_t*)plo);
    v4i16_t b = __builtin_amdgcn_ds_read_tr16_b64_v4i16((LAS v4i16_t*)phi);
    return __builtin_shufflevector(a, b, 0, 1, 2, 3, 4, 5, 6, 7);
}
DI bf16x8 pack8(float a0, float a1, float a2, float a3, float a4, float a5, float a6, float a7) {
    v4u p; p.x = pk2(a0, a1); p.y = pk2(a2, a3); p.z = pk2(a4, a5); p.w = pk2(a6, a7);
    return __builtin_bit_cast(bf16x8, p);
}

using pg8::Unit;
struct EpiInProj {
    static constexpr bool PERM = true, AFTER_DRAIN = false;
    bf16* P; float* IFg; const float* b_if;
    DI void operator()(const f32x4 (&acc)[2][2][4][2], const Unit& u, int wr, int wc, int fr, int fq) const {
        const int row0 = u.pm * 256 + wr * 64 + fr;
        if (u.pn < 38) {
            const int col0 = u.pn * 256 + wc * 32 + 8 * fq; const bool sg = u.pn >= 26;
#pragma unroll
            for (int ai = 0; ai < 2; ++ai)
#pragma unroll
                for (int m = 0; m < 4; ++m) { bf16* rowp = P + pidx((size_t)(row0 + ai * 128 + m * 16), col0);
#pragma unroll
                    for (int bj = 0; bj < 2; ++bj) { f32x4 v0 = acc[ai][bj][m][0], v1 = acc[ai][bj][m][1];
                        if (sg) {
#pragma unroll
                            for (int i = 0; i < 4; ++i) { v0[i] = sigmoidf_(v0[i]); v1[i] = sigmoidf_(v1[i]); } }
                        v4u w; w.x = pk2(v0[0], v0[1]); w.y = pk2(v0[2], v0[3]); w.z = pk2(v1[0], v1[1]); w.w = pk2(v1[2], v1[3]);
                        __builtin_nontemporal_store(w, (v4u*)(rowp + bj * 128)); } }
        } else if (wc == 0 && fq < 2) {
            f32x4 b0 = *(const f32x4*)(b_if + 8 * fq), b1 = *(const f32x4*)(b_if + 8 * fq + 4);
#pragma unroll
            for (int ai = 0; ai < 2; ++ai)
#pragma unroll
                for (int m = 0; m < 4; ++m) { f32x4 v0 = acc[ai][0][m][0] + b0, v1 = acc[ai][0][m][1] + b1;
                    if (fq == 1) {
#pragma unroll
                        for (int i = 0; i < 4; ++i) { v0[i] = fminf(v0[i], 0.f) - __logf(1.0f + __expf(-fabsf(v0[i]))); v1[i] = fminf(v1[i], 0.f) - __logf(1.0f + __expf(-fabsf(v1[i]))); } }
                    float* o = IFg + (size_t)(row0 + ai * 128 + m * 16) * 16 + 8 * fq;
                    *(f32x4*)o = v0; *(f32x4*)(o + 4) = v1; }
        }
    }
};
template <int SIG> struct EpiProj {
    static constexpr bool PERM = true, AFTER_DRAIN = false;
    bf16* P; int ptile0;
    DI void operator()(const f32x4 (&acc)[2][2][4][2], const Unit& u, int wr, int wc, int fr, int fq) const {
        const int row0 = u.pm * 256 + wr * 64 + fr;
        bf16* base = P + (size_t)(ptile0 + u.pn) * ((size_t)TH * 256) + (size_t)row0 * 256 + wc * 32 + 8 * fq;
#pragma unroll
        for (int ai = 0; ai < 2; ++ai)
#pragma unroll
            for (int m = 0; m < 4; ++m) { bf16* rowp = base + (ai * 128 + m * 16) * 256;
#pragma unroll
                for (int bj = 0; bj < 2; ++bj) { f32x4 v0 = acc[ai][bj][m][0], v1 = acc[ai][bj][m][1];
                    if (SIG) {
#pragma unroll
                        for (int i = 0; i < 4; ++i) { v0[i] = sigmoidf_(v0[i]); v1[i] = sigmoidf_(v1[i]); } }
                    v4u w; w.x = pk2(v0[0], v0[1]); w.y = pk2(v0[2], v0[3]); w.z = pk2(v1[0], v1[1]); w.w = pk2(v1[2], v1[3]);
                    __builtin_nontemporal_store(w, (v4u*)(rowp + bj * 128)); } }
    }
};
struct EpiIF {
    static constexpr bool PERM = true, AFTER_DRAIN = false;
    float* IFg; const float* b_if;
    DI void operator()(const f32x4 (&acc)[2][2][4][2], const Unit& u, int wr, int wc, int fr, int fq) const {
        const int row0 = u.pm * 256 + wr * 64 + fr;
        if (wc == 0 && fq < 2) {
            f32x4 b0 = *(const f32x4*)(b_if + 8 * fq), b1 = *(const f32x4*)(b_if + 8 * fq + 4);
#pragma unroll
            for (int ai = 0; ai < 2; ++ai)
#pragma unroll
                for (int m = 0; m < 4; ++m) { f32x4 v0 = acc[ai][0][m][0] + b0, v1 = acc[ai][0][m][1] + b1;
                    if (fq == 1) {
#pragma unroll
                        for (int i = 0; i < 4; ++i) { v0[i] = fminf(v0[i], 0.f) - __builtin_amdgcn_logf(1.0f + __expf(-fabsf(v0[i]))) * 0.6931471805599453f; v1[i] = fminf(v1[i], 0.f) - __builtin_amdgcn_logf(1.0f + __expf(-fabsf(v1[i]))) * 0.6931471805599453f; } }
                    float* o = IFg + (size_t)(row0 + ai * 128 + m * 16) * 16 + 8 * fq;
                    *(f32x4*)o = v0; *(f32x4*)(o + 4) = v1; }
        }
    }
};
struct EpiY1 {
    static constexpr bool PERM = true, AFTER_DRAIN = false;
    const bf16* P; bf16* Y;
    DI void operator()(const f32x4 (&acc)[2][2][4][2], const Unit& u, int wr, int wc, int fr, int fq) const {
        const int row0 = u.pm * 256 + wr * 64 + fr, col0 = u.pn * 256 + wc * 32 + 8 * fq;
#pragma unroll
        for (int ai = 0; ai < 2; ++ai)
#pragma unroll
            for (int m = 0; m < 4; ++m) { const size_t r = (size_t)(row0 + ai * 128 + m * 16);
#pragma unroll
                for (int bj = 0; bj < 2; ++bj) { const int c = col0 + bj * 128; const v4u g = *(const v4u*)(P + pidx(r, 7680 + c));
                    const f32x4 v0 = acc[ai][bj][m][0], v1 = acc[ai][bj][m][1];
                    v4u w; w.x = pk2(v0[0] * lo_f(g.x), v0[1] * hi_f(g.x)); w.y = pk2(v0[2] * lo_f(g.y), v0[3] * hi_f(g.y)); w.z = pk2(v1[0] * lo_f(g.z), v1[1] * hi_f(g.z)); w.w = pk2(v1[2] * lo_f(g.w), v1[3] * hi_f(g.w));
                    *(v4u*)(Y + r * 1024 + c) = w; } }
    }
};
struct EpiYpre {
    static constexpr bool PERM = true, AFTER_DRAIN = false;
    const bf16* P; bf16* Y;
    DI void operator()(const f32x4 (&acc)[2][2][4][2], const Unit& u, int wr, int wc, int fr, int fq) const {
        const int row0 = u.pm * 256 + wr * 64 + fr, col0 = u.pn * 256 + wc * 32 + 8 * fq;
#pragma unroll
        for (int ai = 0; ai < 2; ++ai)
#pragma unroll
            for (int m = 0; m < 4; ++m) { const size_t r = (size_t)(row0 + ai * 128 + m * 16);
#pragma unroll
                for (int bj = 0; bj < 2; ++bj) { const int c = col0 + bj * 128; const v4u g = *(const v4u*)(P + pidx(r, 8704 + c)); const v4u y = *(const v4u*)(Y + r * 1024 + c);
                    const f32x4 a0 = acc[ai][bj][m][0], a1 = acc[ai][bj][m][1];
                    v4u w; w.x = pk2(lo_f(y.x) + a0[0] * lo_f(g.x), hi_f(y.x) + a0[1] * hi_f(g.x)); w.y = pk2(lo_f(y.y) + a0[2] * lo_f(g.y), hi_f(y.y) + a0[3] * hi_f(g.y));
                    w.z = pk2(lo_f(y.z) + a1[0] * lo_f(g.z), hi_f(y.z) + a1[1] * hi_f(g.z)); w.w = pk2(lo_f(y.w) + a1[2] * lo_f(g.w), hi_f(y.w) + a1[3] * hi_f(g.w));
                    *(v4u*)(Y + r * 1024 + c) = w; } }
    }
};
struct EpiResid {
    static constexpr bool PERM = true, AFTER_DRAIN = false;
    const float* base; float* out; const float* gate; int grow0;
    DI void operator()(const f32x4 (&acc)[2][2][4][2], const Unit& u, int wr, int wc, int fr, int fq) const {
        const int row0 = u.pm * 256 + wr * 64 + fr, col0 = u.pn * 256 + wc * 32 + 8 * fq;
        const int b = (grow0 + u.pm * 256) >> 11;
        f32x4 g[2][2];
#pragma unroll
        for (int bj = 0; bj < 2; ++bj) { const float* gp = gate + (size_t)b * 6144 + col0 + bj * 128; g[bj][0] = *(const f32x4*)gp; g[bj][1] = *(const f32x4*)(gp + 4); }
#pragma unroll
        for (int ai = 0; ai < 2; ++ai)
#pragma unroll
            for (int m = 0; m < 4; ++m) { const size_t r = (size_t)(row0 + ai * 128 + m * 16);
#pragma unroll
                for (int bj = 0; bj < 2; ++bj) { const size_t off = r * 1024 + col0 + bj * 128;
                    f32x4 v0 = *(const f32x4*)(base + off), v1 = *(const f32x4*)(base + off + 4);
                    v0 += g[bj][0] * acc[ai][bj][m][0]; v1 += g[bj][1] * acc[ai][bj][m][1];
                    *(f32x4*)(out + off) = v0; *(f32x4*)(out + off + 4) = v1; } }
    }
};
struct EpiResidU2 {
    static constexpr bool PERM = true, AFTER_DRAIN = false;
    const float* base; float* out; const float* ada; const float* g2; bf16* U2; float* rowss; int grow0;
    DI void operator()(const f32x4 (&acc)[2][2][4][2], const Unit& u, int wr, int wc, int fr, int fq) const {
        const int row0 = u.pm * 256 + wr * 64 + fr, col0 = u.pn * 256 + wc * 32 + 8 * fq;
        const int b = (grow0 + u.pm * 256) >> 11;
        f32x4 g[2][2], gm[2][2];
#pragma unroll
        for (int bj = 0; bj < 2; ++bj) { const int c = col0 + bj * 128; const float* gp = ada + (size_t)b * 6144 + 2048 + c; const float* sp = ada + (size_t)b * 6144 + 4096 + c;
            g[bj][0] = *(const f32x4*)gp; g[bj][1] = *(const f32x4*)(gp + 4);
            gm[bj][0] = *(const f32x4*)(g2 + c) * (*(const f32x4*)sp + 1.0f); gm[bj][1] = *(const f32x4*)(g2 + c + 4) * (*(const f32x4*)(sp + 4) + 1.0f); }
#pragma unroll
        for (int ai = 0; ai < 2; ++ai)
#pragma unroll
            for (int m = 0; m < 4; ++m) { const size_t r = (size_t)(row0 + ai * 128 + m * 16); float ss = 0.f;
#pragma unroll
                for (int bj = 0; bj < 2; ++bj) { const size_t off = r * 1024 + col0 + bj * 128;
                    f32x4 v0 = *(const f32x4*)(base + off), v1 = *(const f32x4*)(base + off + 4);
                    v0 += g[bj][0] * acc[ai][bj][m][0]; v1 += g[bj][1] * acc[ai][bj][m][1];
                    *(f32x4*)(out + off) = v0; *(f32x4*)(out + off + 4) = v1;
                    ss += (v0[0] * v0[0] + v0[1] * v0[1]) + (v0[2] * v0[2] + v0[3] * v0[3]) + (v1[0] * v1[0] + v1[1] * v1[1]) + (v1[2] * v1[2] + v1[3] * v1[3]);
                    const f32x4 u0 = v0 * gm[bj][0], u1 = v1 * gm[bj][1];
                    v4u w; w.x = pk2(u0[0], u0[1]); w.y = pk2(u0[2], u0[3]); w.z = pk2(u1[0], u1[1]); w.w = pk2(u1[2], u1[3]);
                    *(v4u*)(U2 + off) = w; }
                ss += __shfl_xor(ss, 16); ss += __shfl_xor(ss, 32);
                if (fq == 0) atomicAdd(rowss + r, ss); }
    }
};
struct EpiRelu2 {
    static constexpr bool PERM = true, AFTER_DRAIN = false;
    bf16* O; const float* rowss; const float* bias2; int grow0;
    DI void operator()(const f32x4 (&acc)[2][2][4][2], const Unit& u, int wr, int wc, int fr, int fq) const {
        const int row0 = u.pm * 256 + wr * 64 + fr, col0 = u.pn * 256 + wc * 32 + 8 * fq;
        const int bb = (grow0 + u.pm * 256) >> 11;
        f32x4 bs[2][2];
#pragma unroll
        for (int bj = 0; bj < 2; ++bj) { const float* bp = bias2 + (size_t)bb * 4096 + col0 + bj * 128; bs[bj][0] = *(const f32x4*)bp; bs[bj][1] = *(const f32x4*)(bp + 4); }
#pragma unroll
        for (int ai = 0; ai < 2; ++ai)
#pragma unroll
            for (int m = 0; m < 4; ++m) { bf16* rowp = O + (size_t)(row0 + ai * 128 + m * 16) * 4096 + col0;
                const float rstd = rsqrtf(rowss[row0 + ai * 128 + m * 16] * (1.0f / 1024.0f) + 1e-6f);
#pragma unroll
                for (int bj = 0; bj < 2; ++bj) { f32x4 v0 = acc[ai][bj][m][0] * rstd + bs[bj][0], v1 = acc[ai][bj][m][1] * rstd + bs[bj][1];
#pragma unroll
                    for (int i = 0; i < 4; ++i) { float a = fmaxf(v0[i], 0.f), b = fmaxf(v1[i], 0.f); v0[i] = a * a; v1[i] = b * b; }
                    v4u w; w.x = pk2(v0[0], v0[1]); w.y = pk2(v0[2], v0[3]); w.z = pk2(v1[0], v1[1]); w.w = pk2(v1[2], v1[3]);
                    *(v4u*)(rowp + bj * 128) = w; } }
    }
};

DI void transpose_item(const float* W, int ldw, int n0src, bf16* WT, int K, int row0dst, LAS float* scr, int kb, int lane) {
    const int k0 = 64 * kb;
#pragma unroll 8
    for (int i = 0; i < 32; ++i) { const int kk = 2 * i + (lane >> 5); scr[kk * 33 + (lane & 31)] = W[(size_t)(k0 + kk) * ldw + n0src + (lane & 31)]; }
    LDS_WAIT(); asm volatile("" ::: "memory");
    const int c = lane & 7;
#pragma unroll
    for (int j = 0; j < 4; ++j) { const int n = (lane >> 3) + 8 * j; const LAS float* s = scr + (8 * c) * 33 + n;
        v4u o; o.x = pk2(s[0 * 33], s[1 * 33]); o.y = pk2(s[2 * 33], s[3 * 33]); o.z = pk2(s[4 * 33], s[5 * 33]); o.w = pk2(s[6 * 33], s[7 * 33]);
        *(v4u*)(WT + (size_t)(row0dst + n) * K + k0 + 8 * c) = o; }
    LDS_WAIT(); asm volatile("" ::: "memory");
}
DI void wseg(const float* W, int ldw, int K, int ncb, int src0, int dst0, bf16* WT, LAS float* scr, int item, int lane) {
    const int kb = item / ncb, nb = item % ncb;
    transpose_item(W, ldw, src0 + 32 * nb, WT, K, dst0 + 32 * nb, scr, kb, lane);
}
DI void ada_item(const float* c, const float* wada, const float* bada, float* ada, LAS float* scr, int item, int lane) {
    const int cb = item % 96, kc = item / 96;
#pragma unroll 4
    for (int i = 0; i < 64; ++i) { const int idx = i * 64 + lane, k = idx >> 5, b = idx & 31; const float v = c[b * 1024 + kc * 128 + k]; scr[idx] = v * sigmoidf_(v); }
    LDS_WAIT(); asm volatile("" ::: "memory");
    float acc[32];
#pragma unroll
    for (int b = 0; b < 32; ++b) acc[b] = 0.f;
    const float* wp = wada + (size_t)(kc * 128) * 6144 + cb * 64 + lane;
#pragma unroll 2
    for (int k = 0; k < 128; ++k) { const float w = wp[(size_t)k * 6144];
#pragma unroll
        for (int b4 = 0; b4 < 8; ++b4) { const f32x4 sv = *(const LAS f32x4*)(scr + k * 32 + b4 * 4);
            acc[4 * b4] += sv[0] * w; acc[4 * b4 + 1] += sv[1] * w; acc[4 * b4 + 2] += sv[2] * w; acc[4 * b4 + 3] += sv[3] * w; } }
    const int col = cb * 64 + lane; const float bias = (kc == 0) ? bada[col] : 0.f;
#pragma unroll
    for (int b = 0; b < 32; ++b) atomicAdd(ada + b * 6144 + col, acc[b] + bias);
    LDS_WAIT(); asm volatile("" ::: "memory");
}
DI void bias2_item(const float* ada, const float* w1, float* bias2, LAS float* scr, int item, int lane) {
    const int cb = item % 64, kc = item / 64;
#pragma unroll 4
    for (int i = 0; i < 64; ++i) { const int idx = i * 64 + lane, k = idx >> 5, b = idx & 31; scr[idx] = ada[(size_t)b * 6144 + 3072 + kc * 128 + k]; }
    LDS_WAIT(); asm volatile("" ::: "memory");
    float acc[32];
#pragma unroll
    for (int b = 0; b < 32; ++b) acc[b] = 0.f;
    const float* wp = w1 + (size_t)(kc * 128) * 4096 + cb * 64 + lane;
#pragma unroll 2
    for (int k = 0; k < 128; ++k) { const float w = wp[(size_t)k * 4096];
#pragma unroll
        for (int b4 = 0; b4 < 8; ++b4) { const f32x4 sv = *(const LAS f32x4*)(scr + k * 32 + b4 * 4);
            acc[4 * b4] += sv[0] * w; acc[4 * b4 + 1] += sv[1] * w; acc[4 * b4 + 2] += sv[2] * w; acc[4 * b4 + 3] += sv[3] * w; } }
    const int col = cb * 64 + lane;
#pragma unroll
    for (int b = 0; b < 32; ++b) atomicAdd(bias2 + b * 4096 + col, acc[b]);
    LDS_WAIT(); asm volatile("" ::: "memory");
}
DI void if_rows(const bf16* Uh, const bf16* Wif, float* IFh, const float* b_if, int item, int lane) {
    const int r32 = lane & 31, h = lane >> 5;
    const bf16* ap = Uh + (size_t)(32 * item + r32) * 1024 + 8 * h; const bf16* bp = Wif + (size_t)r32 * 1024 + 8 * h;
    f32x16 acc;
#pragma unroll
    for (int i = 0; i < 16; ++i) acc[i] = 0.f;
#pragma unroll 8
    for (int kk = 0; kk < 64; ++kk) { const bf16x8 av = *(const bf16x8*)(ap + 16 * kk), bv = *(const bf16x8*)(bp + 16 * kk); acc = MFMA32(av, bv, acc); }
    if (r32 < 16) { const float bias = b_if[r32];
#pragma unroll
        for (int r = 0; r < 16; ++r) { float v = acc[r] + bias;
            if (r32 >= 8) v = fminf(v, 0.f) - __builtin_amdgcn_logf(1.0f + __expf(-fabsf(v))) * 0.6931471805599453f;
            IFh[(size_t)(32 * item + crow(r, h)) * 16 + r32] = v; } }
}
DI void prenorm_rows(const float* X, const float* gvec, const float* ada, int sh_off, int sc_off, bf16* U, int row_lo, int row_hi, int gw, int ngw, int lane) {
    const int nrows = row_hi - row_lo, rpw = (nrows + ngw - 1) / ngw; const int m0 = row_lo + gw * rpw; int m1 = m0 + rpw; if (m1 > row_hi) m1 = row_hi;
    int curb = -1; f32x4 mul[4], add[4], nx[4];
    if (m0 < m1) {
#pragma unroll
        for (int j = 0; j < 4; ++j) nx[j] = *(const f32x4*)(X + (size_t)m0 * 1024 + 4 * lane + 256 * j);
    }
    for (int m = m0; m < m1; ++m) {
        const int b = m >> 11;
        f32x4 v[4]; float ss = 0.f;
#pragma unroll
        for (int j = 0; j < 4; ++j) v[j] = nx[j];
        if (m + 1 < m1) {
#pragma unroll
            for (int j = 0; j < 4; ++j) nx[j] = *(const f32x4*)(X + (size_t)(m + 1) * 1024 + 4 * lane + 256 * j);
        }
        if (b != curb) { curb = b;
#pragma unroll
            for (int j = 0; j < 4; ++j) { const int col = 4 * lane + 256 * j; const f32x4 g = *(const f32x4*)(gvec + col), sc = *(const f32x4*)(ada + (size_t)b * 6144 + sc_off + col);
                mul[j] = g * (sc + 1.0f); add[j] = *(const f32x4*)(ada + (size_t)b * 6144 + sh_off + col); } }
#pragma unroll
        for (int j = 0; j < 4; ++j) ss += (v[j][0] * v[j][0] + v[j][1] * v[j][1]) + (v[j][2] * v[j][2] + v[j][3] * v[j][3]);
        const float rstd = rsqrtf(wave_sum(ss) * (1.0f / 1024.0f) + 1e-6f);
#pragma unroll
        for (int j = 0; j < 4; ++j) { const f32x4 o = (v[j] * rstd) * mul[j] + add[j]; v2u w; w.x = pk2(o[0], o[1]); w.y = pk2(o[2], o[3]);
            *(v2u*)(U + (size_t)m * 1024 + 4 * lane + 256 * j) = w; }
    }
}
constexpr int M_Q = 0, M_K = 9216, M_K2 = 18432, M_V = 30720, M_C = 51200, M_GATE = 71680, M_NPART = 73216, M_SSQ = 75264, M_NVEC = 76288, M_CW = 76544, M_MLG = 79104, M_SLOT = 79616;
DI void mlstm_seq(LAS unsigned char* lds, const bf16* P, const float* IFg, bf16* Hout, const float* conv_w, const float* conv_b, const float* mlg, int seq) {
    int tid_ = threadIdx.x; asm volatile("" : "+v"(tid_));
    const int tid = tid_, wv = __builtin_amdgcn_readfirstlane(tid >> 6), lane = tid & 63, r32 = lane & 31, hh = lane >> 5;
    const int dvs = wv & 3, th = wv >> 2, i16 = lane & 15, q4 = i16 >> 2, p4 = i16 & 3, gg = (lane >> 4) & 1;
    const int bl = seq >> 3, hd = seq & 7; const size_t rowb = (size_t)bl * 2048;
    LAS unsigned char* Qt = lds + M_Q; LAS unsigned char* Kt = lds + M_K; LAS unsigned char* Kt2 = lds + M_K2; LAS unsigned char* Vt = lds + M_V; LAS unsigned char* Cimg = lds + M_C;
    LAS float* gate = (LAS float*)(lds + M_GATE); LAS float* npart = (LAS float*)(lds + M_NPART); LAS float* ssq = (LAS float*)(lds + M_SSQ); LAS float* nvec = (LAS float*)(lds + M_NVEC);
    const int isk = (tid >> 8) & 1, cgp = (tid >> 5) & 7, rg = tid & 31;
    const int chb = isk * 512 + hd * 64 + 8 * cgp, lch = isk * 64 + 8 * cgp;
    f32x16 Cst;
#pragma unroll
    for (int i = 0; i < 16; ++i) Cst[i] = 0.f;
    float n_reg = 0.f, m_run = 0.f;
    for (int i = tid; i < 1280; i += 512) *(LAS v4u*)(Cimg + 16 * i) = (v4u){0u, 0u, 0u, 0u};
    if (tid < 64) nvec[tid] = 0.f;
    LAS float* cw = (LAS float*)(lds + M_CW); LAS float* mlgl = (LAS float*)(lds + M_MLG);
    for (int i = tid; i < 640; i += 512) { const int j = i >> 7, ch = i & 127, gch = (ch >> 6) * 512 + hd * 64 + (ch & 63); cw[i] = (j < 4) ? conv_w[j * 1024 + gch] : conv_b[gch]; }
    if (tid < 128) mlgl[tid] = mlg[hd * 128 + tid];
    __syncthreads();
    v4u qk[5], vv[2]; float pli = 0.f, plf = 0.f;
#define ML_LOAD(c_) do { const int t0_ = 64 * (c_); \
        { _Pragma("unroll") for (int i = 0; i < 5; ++i) { const int t_ = t0_ + 2 * rg - 3 + i; \
            qk[i] = (t_ >= 0) ? *(const v4u*)(P + pidx(rowb + t_, 4608 + chb)) : (v4u){0u, 0u, 0u, 0u}; } } \
        _Pragma("unroll") for (int i = 0; i < 2; ++i) { const int idx_ = tid + 512 * i, s_ = idx_ >> 4, ch_ = idx_ & 15; \
            vv[i] = *(const v4u*)(P + pidx(rowb + t0_ + s_, 5632 + hd * 128 + 8 * ch_)); } \
        if (wv == 0) { const size_t r_ = (rowb + t0_ + lane) * 16; pli = IFg[r_ + hd]; plf = IFg[r_ + 8 + hd]; } } while (0)
#define ML_WRITE() do { \
        { float wj[4][8], bs[8]; \
            _Pragma("unroll") for (int j = 0; j < 4; ++j) { const f32x4 a_ = *(const LAS f32x4*)(cw + j * 128 + lch), b_ = *(const LAS f32x4*)(cw + j * 128 + lch + 4); \
                wj[j][0] = a_[0]; wj[j][1] = a_[1]; wj[j][2] = a_[2]; wj[j][3] = a_[3]; wj[j][4] = b_[0]; wj[j][5] = b_[1]; wj[j][6] = b_[2]; wj[j][7] = b_[3]; } \
            { const f32x4 a_ = *(const LAS f32x4*)(cw + 512 + lch), b_ = *(const LAS f32x4*)(cw + 512 + lch + 4); bs[0] = a_[0]; bs[1] = a_[1]; bs[2] = a_[2]; bs[3] = a_[3]; bs[4] = b_[0]; bs[5] = b_[1]; bs[6] = b_[2]; bs[7] = b_[3]; } \
            _Pragma("unroll") for (int rr = 0; rr < 2; ++rr) { float y_[8]; \
                _Pragma("unroll") for (int e = 0; e < 8; ++e) y_[e] = bs[e]; \
                _Pragma("unroll") for (int j = 0; j < 4; ++j) { const v4u x_ = *(const LAS v4u*)(slot + (rr + j) * 8192); \
                    y_[0] += wj[j][0] * lo_f(x_.x); y_[1] += wj[j][1] * hi_f(x_.x); y_[2] += wj[j][2] * lo_f(x_.y); y_[3] += wj[j][3] * hi_f(x_.y); \
                    y_[4] += wj[j][4] * lo_f(x_.z); y_[5] += wj[j][5] * hi_f(x_.z); y_[6] += wj[j][6] * lo_f(x_.w); y_[7] += wj[j][7] * hi_f(x_.w); } \
                _Pragma("unroll") for (int e = 0; e < 8; ++e) { y_[e] = y_[e] * sigmoidf_(y_[e]); if (isk) y_[e] *= 0.125f; } \
                v4u o_; o_.x = pk2(y_[0], y_[1]); o_.y = pk2(y_[2], y_[3]); o_.z = pk2(y_[4], y_[5]); o_.w = pk2(y_[6], y_[7]); \
                const int s_ = 2 * rg + rr; \
                if (!isk) *(LAS v4u*)(Qt + s_ * 144 + 16 * cgp) = o_; else { *(LAS v4u*)(Kt + s_ * 144 + 16 * cgp) = o_; *(LAS v4u*)(Kt2 + s_ * 192 + 16 * cgp) = o_; } } } \
        _Pragma("unroll") for (int i = 0; i < 2; ++i) { const int idx_ = tid + 512 * i, s_ = idx_ >> 4, ch_ = idx_ & 15; *(LAS v4u*)(Vt + s_ * 320 + 16 * ch_) = *(const LAS v4u*)(slot + (5 + i) * 8192); } \
        ML_GSTORE(); } while (0)
#define ML_GCOMP() do { if (wv == 0) { float b_ = plf2; \
            _Pragma("unroll") for (int o = 1; o < 64; o <<= 1) { const float v_ = __shfl_up(b_, o); if (lane >= o) b_ += v_; } \
            const float d_ = pli2 - b_; float cm_ = d_; \
            _Pragma("unroll") for (int o = 1; o < 64; o <<= 1) { const float v_ = __shfl_up(cm_, o); if (lane >= o) cm_ = fmaxf(cm_, v_); } \
            const float M_ = fmaxf(m_run, cm_); const float bend_ = __shfl(b_, 63), M63_ = __shfl(M_, 63); \
            g_d = d_; g_M = M_; g_i = __expf(m_run - M_); g_e = __expf(-(b_ + M_)); g_w = __expf(d_ - M63_); g_dec = __expf(m_run - M63_); \
            m_run = bend_ + M63_; } } while (0)
#define ML_GSTORE() do { if (wv == 0) { gate[lane] = g_d; gate[64 + lane] = g_M; gate[128 + lane] = g_i; gate[192 + lane] = g_e; gate[256 + lane] = g_w; if (lane == 0) gate[320] = g_dec; } } while (0)
    float g_d = 0.f, g_M = 0.f, g_i = 0.f, g_e = 0.f, g_w = 0.f, g_dec = 0.f;

    LAS unsigned char* slot = lds + M_SLOT + tid * 16; float pli2 = 0.f, plf2 = 0.f;
#define ML_PARK() do { _Pragma("unroll") for (int i = 0; i < 5; ++i) *(LAS v4u*)(slot + i * 8192) = qk[i]; *(LAS v4u*)(slot + 5 * 8192) = vv[0]; *(LAS v4u*)(slot + 6 * 8192) = vv[1]; pli2 = pli; plf2 = plf; } while (0)
    ML_LOAD(0);
    ML_PARK();
    ML_GCOMP();
    ML_WRITE();
    ML_LOAD(1);
    for (int c = 0; c < 32; ++c) {
        __syncthreads();
        if (c < 31) ML_PARK();
        if (c < 30) ML_LOAD(c + 2);
        if (c < 31) ML_GCOMP();
        const int t = 32 * th + r32; const size_t row = rowb + 64 * c + t;
        v2u og[4];
#pragma unroll
        for (int rq = 0; rq < 4; ++rq) og[rq] = *(const v2u*)(P + pidx(row, 6656 + hd * 128 + 32 * dvs + 8 * rq + 4 * hh));
        const float Mt = gate[64 + t], it = gate[128 + t], et = gate[192 + t], dec = gate[320];
        bf16x8 qf[4];
#pragma unroll
        for (int kk = 0; kk < 4; ++kk) qf[kk] = *(const LAS bf16x8*)(Qt + t * 144 + 32 * kk + 16 * hh);
        f32x16 sacc[2];
#pragma unroll
        for (int st = 0; st < 2; ++st) {
#pragma unroll
            for (int i = 0; i < 16; ++i) sacc[st][i] = 0.f;
            if (st <= th) {
#pragma unroll
                for (int kk = 0; kk < 4; ++kk) { const bf16x8 a = *(const LAS bf16x8*)(Kt + (32 * st + r32) * 144 + 32 * kk + 16 * hh); sacc[st] = MFMA32(a, qf[kk], sacc[st]); } }
        }
        float rowsum = 0.f; bf16x8 Wf[4];
#pragma unroll
        for (int st = 0; st < 2; ++st) {
            if (st <= th) {
#pragma unroll
            for (int rq = 0; rq < 4; ++rq) { const f32x4 d4 = *(const LAS f32x4*)(gate + 32 * st + 8 * rq + 4 * hh);
#pragma unroll
                for (int i = 0; i < 4; ++i) { const int s = 32 * st + 8 * rq + 4 * hh + i; const float e = __expf(d4[i] - Mt); const float w = (s <= t) ? sacc[st][4 * rq + i] * e : 0.f; rowsum += w; sacc[st][4 * rq + i] = w; } } }
            Wf[2 * st] = pack8(sacc[st][0], sacc[st][1], sacc[st][2], sacc[st][3], sacc[st][4], sacc[st][5], sacc[st][6], sacc[st][7]);
            Wf[2 * st + 1] = pack8(sacc[st][8], sacc[st][9], sacc[st][10], sacc[st][11], sacc[st][12], sacc[st][13], sacc[st][14], sacc[st][15]);
        }
        float qn = 0.f;
#pragma unroll
        for (int kk = 0; kk < 4; ++kk) { const f32x4 n0 = *(const LAS f32x4*)(nvec + 16 * kk + 8 * hh), n1 = *(const LAS f32x4*)(nvec + 16 * kk + 8 * hh + 4); const v4u q = __builtin_bit_cast(v4u, qf[kk]);
            qn += lo_f(q.x) * n0[0] + hi_f(q.x) * n0[1] + lo_f(q.y) * n0[2] + hi_f(q.y) * n0[3] + lo_f(q.z) * n1[0] + hi_f(q.z) * n1[1] + lo_f(q.w) * n1[2] + hi_f(q.w) * n1[3]; }
        qn += __shfl_xor(qn, 32); rowsum += __shfl_xor(rowsum, 32);
        const float nq = rowsum + it * qn; const float invd = 1.0f / fmaxf(fabsf(nq), et);
        bf16x8 vf[4];
#pragma unroll
        for (int k4 = 0; k4 < 4; ++k4) { LAS unsigned char* p = Vt + (16 * k4 + 4 * hh + q4) * 320 + 2 * (32 * dvs + 16 * gg + 4 * p4); vf[k4] = tr8(p, p + 8 * 320); }
        f32x16 num, qc;
#pragma unroll
        for (int i = 0; i < 16; ++i) { num[i] = 0.f; qc[i] = 0.f; }
#pragma unroll
        for (int k4 = 0; k4 < 4; ++k4) if (k4 < 2 * (th + 1)) num = MFMA32(vf[k4], Wf[k4], num);
#pragma unroll
        for (int kk = 0; kk < 4; ++kk) { LAS unsigned char* p = Cimg + (16 * kk + 8 * hh + q4) * 320 + 2 * (32 * dvs + 16 * gg + 4 * p4); const bf16x8 cf = tr8(p, p + 4 * 320); qc = MFMA32(cf, qf[kk], qc); }
        float hv[16]; float ss = 0.f;
#pragma unroll
        for (int i = 0; i < 16; ++i) { hv[i] = (num[i] + it * qc[i]) * invd; ss += hv[i] * hv[i]; }
        ss += __shfl_xor(ss, 32);
        if (hh == 0) ssq[dvs * 64 + t] = ss;
#pragma unroll
        for (int i = 0; i < 16; ++i) Cst[i] *= dec;
#pragma unroll
        for (int k4 = 0; k4 < 4; ++k4) { const f32x4 wa = *(const LAS f32x4*)(gate + 256 + 16 * k4 + 4 * hh), wb = *(const LAS f32x4*)(gate + 256 + 16 * k4 + 8 + 4 * hh);
            LAS unsigned char* p = Kt2 + (16 * k4 + 4 * hh + q4) * 192 + 2 * (32 * th + 16 * gg + 4 * p4); const v4u kq = __builtin_bit_cast(v4u, tr8(p, p + 8 * 192));
            const bf16x8 kf2 = pack8(lo_f(kq.x) * wa[0], hi_f(kq.x) * wa[1], lo_f(kq.y) * wa[2], hi_f(kq.y) * wa[3], lo_f(kq.z) * wb[0], hi_f(kq.z) * wb[1], lo_f(kq.w) * wb[2], hi_f(kq.w) * wb[3]);
            Cst = MFMA32(vf[k4], kf2, Cst); }
        { float np = 0.f;
#pragma unroll
            for (int i = 0; i < 8; ++i) { const int s = 8 * wv + i; np += gate[256 + s] * bf2f(*(const LAS unsigned short*)(Kt + s * 144 + 2 * lane)); }
            npart[wv * 64 + lane] = np; }
        __syncthreads();
        const float tot = ssq[t] + ssq[64 + t] + ssq[128 + t] + ssq[192 + t]; const float rstd = rsqrtf(tot * (1.0f / 128.0f) + 1e-6f);
#pragma unroll
        for (int rq = 0; rq < 4; ++rq) { const int dv = 32 * dvs + 8 * rq + 4 * hh; const f32x4 gl = *(const LAS f32x4*)(mlgl + dv);
            const float o0 = hv[4 * rq] * rstd * gl[0] * lo_f(og[rq].x), o1 = hv[4 * rq + 1] * rstd * gl[1] * hi_f(og[rq].x), o2 = hv[4 * rq + 2] * rstd * gl[2] * lo_f(og[rq].y), o3 = hv[4 * rq + 3] * rstd * gl[3] * hi_f(og[rq].y);
            v2u w; w.x = pk2(o0, o1); w.y = pk2(o2, o3); *(v2u*)(Hout + row * 1024 + hd * 128 + dv) = w;
            v2u cw; cw.x = pk2(Cst[4 * rq], Cst[4 * rq + 1]); cw.y = pk2(Cst[4 * rq + 2], Cst[4 * rq + 3]);
            *(LAS v2u*)(Cimg + (32 * th + r32) * 320 + 2 * dv) = cw; }
        if (wv == 5) { float s = 0.f;
#pragma unroll
            for (int w = 0; w < 8; ++w) s += npart[w * 64 + lane];
            n_reg = dec * n_reg + s; nvec[lane] = n_reg; }
        if (c < 31) ML_WRITE();
    }
#undef ML_LOAD
#undef ML_PARK
#undef ML_GCOMP
#undef ML_GSTORE
#undef ML_WRITE
    __syncthreads();
}

constexpr int A_HALF = 39168, A_K = 0, A_V = 17408, A_BIAS = 37888, A_GQ = 78336, A_GK = 78848, A_UNIT = 79360;
DI void attn_unit(LAS unsigned char* lds, const bf16* P, bf16* OG, float* LSE, const float* relb, int u) {
    int tid_ = threadIdx.x; asm volatile("" : "+v"(tid_));
    const int tid = tid_, hw = __builtin_amdgcn_readfirstlane(tid >> 8), htid = tid & 255, w = __builtin_amdgcn_readfirstlane((tid >> 6) & 3), lane = tid & 63, r32 = lane & 31, hh = lane >> 5;
    const int i16 = lane & 15, q4 = i16 >> 2, p4 = i16 & 3, gg = (lane >> 4) & 1;
    const int bp = u & 7, t2 = u >> 3, head = t2 % 12, bl = t2 / 12, g = head >> 2, hs = head & 3;
    const int dil = (g == 0) ? 1 : ((g == 1) ? 4 : 16), nbs = (g == 0) ? 4 : ((g == 1) ? 2 : 0);
    const int blk = 2 * bp + hw, r = blk >> nbs, qb = blk & ((1 << nbs) - 1);
    const size_t rowb = (size_t)bl * 2048;
    LAS unsigned char* Kl = lds + hw * A_HALF + A_K; LAS unsigned char* Vl = lds + hw * A_HALF + A_V; LAS float* biasT = (LAS float*)(lds + hw * A_HALF + A_BIAS);
    const LAS float* gq = (const LAS float*)(lds + A_GQ);
#pragma unroll
    for (int jj = 0; jj < 2; ++jj) { const int j = htid + 256 * jj;
        if (j < 320) { const int delta = j - 96; float val = -1e30f;
            if (delta >= 0 && delta <= 128) { const int dist = delta * dil; int bucket;
                if (dist < 16) bucket = dist; else { const float d = (float)dist; int lg = 16 + (int)(logf(d / 16.0f) / logf(128.0f) * 16.0f); bucket = lg < 31 ? lg : 31; }
                val = relb[bucket * 12 + head] * 1.4426950408889634f; }
            biasT[j] = val; } }
    const int kr = htid >> 2, qt = htid & 3;
    v4u kreg[4], vreg[4];
#define AT_LOAD(t_) do { const int ks0_ = 128 * (qb - 1) + 64 * (t_); if (ks0_ >= 0) { const size_t ktok_ = rowb + (size_t)(ks0_ + kr) * dil + r; const bf16* kp_ = P + pidx(ktok_, 1536 + head * 128 + qt * 32); \
        _Pragma("unroll") for (int i = 0; i < 4; ++i) { kreg[i] = *(const v4u*)(kp_ + 8 * i); vreg[i] = *(const v4u*)(kp_ + (size_t)6 * TH * 256 + 8 * i); } } } while (0)
    const int tstart = (g == 2) ? 2 : 0;
    AT_LOAD(tstart);
    const int qmin = 128 * qb + 32 * w, qsub = qmin + r32; const size_t qtok = rowb + (size_t)qsub * dil + r;
    bf16x8 qf[8];
    { const bf16* qrow = P + pidx(qtok, head * 128); v4u qraw[8]; float ss = 0.f;
#pragma unroll
        for (int kk = 0; kk < 8; ++kk) { qraw[kk] = *(const v4u*)(qrow + 16 * kk + 8 * hh); const v4u q = qraw[kk];
            ss += lo_f(q.x) * lo_f(q.x) + hi_f(q.x) * hi_f(q.x) + lo_f(q.y) * lo_f(q.y) + hi_f(q.y) * hi_f(q.y) + lo_f(q.z) * lo_f(q.z) + hi_f(q.z) * hi_f(q.z) + lo_f(q.w) * lo_f(q.w) + hi_f(q.w) * hi_f(q.w); }
        ss += __shfl_xor(ss, 32);
        const float rs = rsqrtf(ss * (1.0f / 128.0f) + 1e-6f) * (0.08838834764831845f * 1.4426950408889634f);
#pragma unroll
        for (int kk = 0; kk < 8; ++kk) { const v4u q = qraw[kk]; const f32x4 g0 = *(const LAS f32x4*)(gq + 16 * kk + 8 * hh), g1 = *(const LAS f32x4*)(gq + 16 * kk + 8 * hh + 4);
            qf[kk] = pack8(lo_f(q.x) * rs * g0[0], hi_f(q.x) * rs * g0[1], lo_f(q.y) * rs * g0[2], hi_f(q.y) * rs * g0[3], lo_f(q.z) * rs * g1[0], hi_f(q.z) * rs * g1[1], lo_f(q.w) * rs * g1[2], hi_f(q.w) * rs * g1[3]); }
    }
    f32x16 O[4];
#pragma unroll
    for (int dt = 0; dt < 4; ++dt)
#pragma unroll
        for (int i = 0; i < 16; ++i) O[dt][i] = 0.f;
    float m = -1e30f, l = 0.f;
    for (int t = tstart; t < 4; ++t) {
        const int ks0 = 128 * (qb - 1) + 64 * t; const bool tvalid = ks0 >= 0;
        __syncthreads();
        if (tvalid) {
            float ss = 0.f;
#pragma unroll
            for (int i = 0; i < 4; ++i) { const v4u q = kreg[i];
                ss += lo_f(q.x) * lo_f(q.x) + hi_f(q.x) * hi_f(q.x) + lo_f(q.y) * lo_f(q.y) + hi_f(q.y) * hi_f(q.y) + lo_f(q.z) * lo_f(q.z) + hi_f(q.z) * hi_f(q.z) + lo_f(q.w) * lo_f(q.w) + hi_f(q.w) * hi_f(q.w); }
            ss += __shfl_xor(ss, 1); ss += __shfl_xor(ss, 2);
            const float rs = rsqrtf(ss * (1.0f / 128.0f) + 1e-6f);
#pragma unroll
            for (int i = 0; i < 4; ++i) { const v4u q = kreg[i];
                v4u o; o.x = pk2(lo_f(q.x) * rs, hi_f(q.x) * rs); o.y = pk2(lo_f(q.y) * rs, hi_f(q.y) * rs); o.z = pk2(lo_f(q.z) * rs, hi_f(q.z) * rs); o.w = pk2(lo_f(q.w) * rs, hi_f(q.w) * rs);
                *(LAS v4u*)(Kl + kr * 272 + qt * 64 + 16 * i) = o; *(LAS v4u*)(Vl + kr * 320 + qt * 64 + 16 * i) = vreg[i]; }
        }
        __syncthreads();
        if (t < 3) AT_LOAD(t + 1);
        const bool active = tvalid && (qmin + 31 - ks0 >= 0) && (qmin - (ks0 + 63) <= 128);
        if (active) {
            f32x16 p0, p1;
#pragma unroll
            for (int i = 0; i < 16; ++i) { p0[i] = 0.f; p1[i] = 0.f; }
#pragma unroll
            for (int kk = 0; kk < 8; ++kk) { const bf16x8 a0 = *(const LAS bf16x8*)(Kl + r32 * 272 + 32 * kk + 16 * hh), a1 = *(const LAS bf16x8*)(Kl + (32 + r32) * 272 + 32 * kk + 16 * hh);
                p0 = MFMA32(a0, qf[kk], p0); p1 = MFMA32(a1, qf[kk], p1); }
            float mx = -1e30f;
            {
                const LAS float* bp = biasT + (qsub - ks0 + 96 - 4 * hh - 63);
#pragma unroll
                for (int i = 0; i < 16; ++i) { const int ko = (i & 3) + 8 * (i >> 2);
                    p0[i] += bp[63 - ko]; p1[i] += bp[63 - 32 - ko]; mx = fmaxf(mx, fmaxf(p0[i], p1[i])); }
            }
            mx = fmaxf(mx, __shfl_xor(mx, 32));
            const float mnew = fmaxf(m, mx), alpha = __builtin_amdgcn_exp2f(m - mnew); m = mnew;
            float ls = 0.f;
#pragma unroll
            for (int i = 0; i < 16; ++i) { p0[i] = __builtin_amdgcn_exp2f(p0[i] - mnew); p1[i] = __builtin_amdgcn_exp2f(p1[i] - mnew); ls += p0[i] + p1[i]; }
            l = l * alpha + ls;
            if (__ballot(alpha != 1.0f) != 0ull) {
#pragma unroll
            for (int dt = 0; dt < 4; ++dt)
#pragma unroll
                for (int i = 0; i < 16; ++i) O[dt][i] *= alpha;
            }
#pragma unroll
            for (int k4 = 0; k4 < 4; ++k4) {
                bf16x8 pf;
                if (k4 == 0) pf = pack8(p0[0], p0[1], p0[2], p0[3], p0[4], p0[5], p0[6], p0[7]);
                else if (k4 == 1) pf = pack8(p0[8], p0[9], p0[10], p0[11], p0[12], p0[13], p0[14], p0[15]);
                else if (k4 == 2) pf = pack8(p1[0], p1[1], p1[2], p1[3], p1[4], p1[5], p1[6], p1[7]);
                else pf = pack8(p1[8], p1[9], p1[10], p1[11], p1[12], p1[13], p1[14], p1[15]);
#pragma unroll
                for (int dt = 0; dt < 4; ++dt) { LAS unsigned char* p = Vl + (16 * k4 + 4 * hh + q4) * 320 + 2 * (32 * dt + 16 * gg + 4 * p4); const bf16x8 va = tr8(p, p + 8 * 320); O[dt] = MFMA32(va, pf, O[dt]); }
            }
        }
    }
#undef AT_LOAD
    l += __shfl_xor(l, 32);
    const float inv = 1.0f / l;
    bf16* orow = OG + (size_t)g * ((size_t)TH * 512) + qtok * 512 + hs * 128;
#pragma unroll
    for (int dt = 0; dt < 4; ++dt)
#pragma unroll
        for (int rq = 0; rq < 4; ++rq) { v2u wv; wv.x = pk2(O[dt][4 * rq] * inv, O[dt][4 * rq + 1] * inv); wv.y = pk2(O[dt][4 * rq + 2] * inv, O[dt][4 * rq + 3] * inv);
            *(v2u*)(orow + 32 * dt + 8 * rq + 4 * hh) = wv; }
    if (hh == 0) LSE[qtok * 12 + head] = m * 0.6931471805599453f + __logf(l);
}

#define XB_TMO      128
#define XB_XCNT(j)  (256  + 64 * (j))
#define XB_XSUB(j)  (1280 + 64 * (j))
#define XB_XGEN(j)  (2304 + 64 * (j))
#define XB_TOP      3328
#define XB_TOPGEN   3392
#define XCD_BAR_WORDS 3456
#define XB_SPIN_CAP (1u << 18)

__device__ __forceinline__ unsigned xb_ld(unsigned* p)              { return __hip_atomic_load(p, __ATOMIC_RELAXED, __HIP_MEMORY_SCOPE_AGENT); }
__device__ __forceinline__ unsigned xb_add(unsigned* p, unsigned v) { return __hip_atomic_fetch_add(p, v, __ATOMIC_RELAXED, __HIP_MEMORY_SCOPE_AGENT); }
__device__ __forceinline__ unsigned xb_xcc_id() { return (unsigned)__builtin_amdgcn_s_getreg((3 << 11) | 20) & 0xFu; }
#define XB_SPIN(cond, bar) do { unsigned _sp = 0; while (cond) { __builtin_amdgcn_s_sleep(1); \
    if ((++_sp & 255u) == 0u) { if (xb_ld(&(bar)[XB_TMO])) break; if (_sp > XB_SPIN_CAP) { atomicAdd(&(bar)[XB_TMO], 1u); break; } } } } while (0)

struct XcdBarrier {
    unsigned* bar; unsigned x;
    volatile LAS unsigned* st;
};

__device__ __forceinline__ XcdBarrier xcd_barrier_post(unsigned* bar, volatile LAS unsigned* st) {
    XcdBarrier b; b.bar = bar; b.x = xb_xcc_id(); b.st = st;
    if (threadIdx.x == 0) (void)xb_add(&bar[XB_XCNT(b.x)], 1u);
    return b;
}
__device__ __forceinline__ void xcd_barrier_complete(unsigned* bar, unsigned x, unsigned& nloc, unsigned& nx) {
    const unsigned G = gridDim.x * gridDim.y * gridDim.z;
    unsigned sum, cnt, mine, sp = 0u;
    for (;;) {
        sum = 0u; cnt = 0u; mine = 0u;
#pragma unroll
        for (unsigned j = 0; j < 16; ++j) { const unsigned c = xb_ld(&bar[XB_XCNT(j)]); sum += c; cnt += (c > 0u) ? 1u : 0u; mine = (j == x) ? c : mine; }
        if (sum == G) break;
        __builtin_amdgcn_s_sleep(1);
        if ((++sp & 255u) == 0u) { if (xb_ld(&bar[XB_TMO])) break; if (sp > XB_SPIN_CAP) { atomicAdd(&bar[XB_TMO], 1u); break; } }
    }
    nloc = mine > 0u ? mine : 1u; nx = cnt > 0u ? cnt : 1u;
}

__device__ __forceinline__ void xcd_barrier(const XcdBarrier& b) {
    asm volatile("s_waitcnt vmcnt(0)" ::: "memory");
    __syncthreads();
    if (threadIdx.x == 0) {
        unsigned* bar = b.bar;
        __builtin_amdgcn_s_waitcnt(0);
        unsigned nloc = b.st[0], nx = b.st[1];
        if (nloc == 0u) { xcd_barrier_complete(bar, b.x, nloc, nx); b.st[0] = nloc; b.st[1] = nx; }
        const unsigned old = xb_add(&bar[XB_XSUB(b.x)], 1u);
        const unsigned gen = old / nloc;
        if (old + 1u == (gen + 1u) * nloc) {
            __builtin_amdgcn_fence(__ATOMIC_RELEASE, "agent");
            asm volatile("s_waitcnt vmcnt(0)" ::: "memory");
            const unsigned og = xb_add(&bar[XB_TOP], 1u);
            const unsigned tg = og / nx;
            if (og + 1u == (tg + 1u) * nx) xb_add(&bar[XB_TOPGEN], 1u);
            else XB_SPIN(xb_ld(&bar[XB_TOPGEN]) == tg, bar);
            __builtin_amdgcn_fence(__ATOMIC_ACQUIRE, "agent");
            xb_add(&bar[XB_XGEN(b.x)], 1u);
            asm volatile("s_waitcnt vmcnt(0)" ::: "memory");
        } else {
            XB_SPIN(xb_ld(&bar[XB_XGEN(b.x)]) == gen, bar);
            __builtin_amdgcn_fence(__ATOMIC_ACQUIRE, "agent");
            asm volatile("s_waitcnt vmcnt(0)" ::: "memory");
        }
    }
    __syncthreads();
}

#ifndef REP_G1
#define REP_G1 1
#endif
#ifndef REP_ML
#define REP_ML 1
#endif
#ifndef REP_ATT
#define REP_ATT 1
#endif
#ifndef REP_MIX
#define REP_MIX 1
#endif
#ifndef REP_FFN
#define REP_FFN 1
#endif
struct Args { const float* in[19]; float* out; unsigned char* ws; };

__global__ void __launch_bounds__(512, 2) fwd_mega(Args a) {
    extern __shared__ __attribute__((aligned(16))) unsigned char lds_raw[];
    LAS unsigned char* lds = (LAS unsigned char*)lds_raw;
    cg::grid_group grid = cg::this_grid();
#define FRESH_IDS() int tid = threadIdx.x; asm volatile("" : "+v"(tid)); const int lane = tid & 63, wave = __builtin_amdgcn_readfirstlane(tid >> 6), gw = bx * 8 + wave; (void)lane; (void)gw
    const int G = gridDim.x, bx = blockIdx.x, ngw = G * 8;
    unsigned char* ws = a.ws;
    float* ada = (float*)(ws + WS_ADA); unsigned* ctl = (unsigned*)(ws + WS_CTL); float* rowss = (float*)(ws + WS_ROWSS); float* bias2 = (float*)(ws + WS_BIAS2);
    bf16* WinT = (bf16*)(ws + WS_WIN); bf16* WattT = (bf16*)(ws + WS_WATT); bf16* WmlT = (bf16*)(ws + WS_WML); bf16* WoutT = (bf16*)(ws + WS_WOUT); bf16* Wff1T = (bf16*)(ws + WS_WFF1); bf16* Wff2T = (bf16*)(ws + WS_WFF2);
    float* IFg = (float*)(ws + WS_IF); bf16* U = (bf16*)(ws + WS_U); bf16* P = (bf16*)(ws + WS_P); bf16* HID = (bf16*)(ws + WS_HID); bf16* OG = (bf16*)(ws + WS_OG); bf16* YPRE = (bf16*)(ws + WS_YPRE);
    float* LSE = (float*)(ws + WS_LSE); bf16* Hb = (bf16*)(ws + WS_H); bf16* ATT = (bf16*)(ws + WS_ATT);
    const float* x = a.in[0]; float* out = a.out;
    volatile LAS unsigned* bst = (volatile LAS unsigned*)(lds + LDS_BYTES - 16);
    if (threadIdx.x == 0) { bst[0] = 0u; bst[1] = 0u; }
    __syncthreads();
    (void)xcd_barrier_post(ctl + 4096, bst);
#define GBAR() do { XcdBarrier xb_; xb_.bar = (unsigned*)(a.ws + WS_CTL) + 4096; xb_.x = xb_xcc_id(); xb_.st = (volatile LAS unsigned*)(lds + LDS_BYTES - 16); xcd_barrier(xb_); } while (0)

    {
        FRESH_IDS();
        LAS float* scr = (LAS float*)(lds + wave * 16384);
        constexpr int I0 = 3840, I1 = 1024, I2 = 16, I3 = 256, I4 = 512, I5 = 512, I6 = 2048, I7 = 2048, I8 = 768;
        constexpr int NIT = I0 + I1 + I2 + I3 + I4 + I5 + I6 + I7 + I8;
        for (int it = gw; it < NIT; it += ngw) {
            int r = it;
            if (r < I8) { ada_item(a.in[1], a.in[2], a.in[3], ada, scr, r, lane); continue; } r -= I8;
            if (r < I0) { wseg(a.in[6], DIN, 1024, 240, 0, 0, WinT, scr, r, lane); continue; } r -= I0;
            if (r < I1) { wseg(a.in[6], DIN, 1024, 64, 7696, 7680, WinT, scr, r, lane); continue; } r -= I1;
            if (r < I2) { wseg(a.in[6], DIN, 1024, 1, 7680, 9728, WinT, scr, r, lane); continue; } r -= I2;
            if (r < I3) { wseg(a.in[14], 1024, 512, 32, 0, 0, WattT, scr, r, lane); continue; } r -= I3;
            if (r < I4) { wseg(a.in[15], 1024, 1024, 32, 0, 0, WmlT, scr, r, lane); continue; } r -= I4;
            if (r < I5) { wseg(a.in[16], 1024, 1024, 32, 0, 0, WoutT, scr, r, lane); continue; } r -= I5;
            if (r < I6) { wseg(a.in[17], 4096, 1024, 128, 0, 0, Wff1T, scr, r, lane); continue; } r -= I6;
            wseg(a.in[18], 1024, 4096, 32, 0, 0, Wff2T, scr, r, lane);
        }
    }
    grid.sync();
    { FRESH_IDS(); LAS float* scr = (LAS float*)(lds + wave * 16384);
      for (int it = gw; it < 512; it += ngw) bias2_item(ada, a.in[17], bias2, scr, it, lane);
      prenorm_rows(x, a.in[4], ada, 0, 1024, U, 0, T_ALL, gw, ngw, lane); }
    GBAR();

    for (int hb = 0; hb < 2; ++hb) {
        const int grow0 = hb * TH;
        for (int rep = 0; rep < REP_G1; ++rep) {
        { pg8::Gemm g{U + (size_t)grow0 * 1024, WinT, TH, 38 * 256, 1024}; pg8::StaticOrder S; S.init(TH, 38 * 256, G, bx);
          EpiInProj E{P, IFg + (size_t)grow0 * 16, a.in[7]};
          pg8::gemm_phase<EpiInProj, pg8::StaticOrder, true, true>(lds, g, S, E); }
        __syncthreads();
        { FRESH_IDS();
          if ((gw & 1) == 0 && (gw >> 1) < TH / 32) if_rows(U + (size_t)grow0 * 1024, WinT + (size_t)9728 * 1024, IFg + (size_t)grow0 * 16, a.in[7], gw >> 1, lane); }
        }
        GBAR();
        for (int rep = 0; rep < REP_MIX; ++rep)
        {
            FRESH_IDS();
            for (int r2 = 0; r2 < REP_ML; ++r2) for (int seq = bx; seq < 128; seq += G) mlstm_seq(lds, P, IFg + (size_t)grow0 * 16, Hb, a.in[8], a.in[9], a.in[13], seq);
            if (tid < 128) ((LAS float*)(lds + A_GQ))[tid] = a.in[10][tid] * a.in[11][tid];
            LAS int* s_unit = (LAS int*)(lds + A_UNIT);
            for (int r3 = 0; r3 < REP_ATT; ++r3) {
                unsigned* ctr = ctl + 64 * hb + 128 * rep + 256 * r3;
                __syncthreads();
                if (tid == 0) s_unit[0] = (int)atomicAdd(ctr, 1u);
                __syncthreads();
                int u = s_unit[0], par = 0;
                while (u < 1536) {
                    int nxt = 0;
                    if (tid == 0) nxt = (int)atomicAdd(ctr, 1u);
                    attn_unit(lds, P, OG, LSE, a.in[12], u);
                    if (tid == 0) s_unit[par ^ 1] = nxt;
                    __syncthreads();
                    par ^= 1; u = s_unit[par];
                }
            }
        }
        GBAR();
        { FRESH_IDS();
        for (int i = bx * 512 + tid; i < TH * 64; i += G * 512) {
            const int tok = i >> 6, rem = i & 63, hs = rem >> 4, ch = rem & 15;
            const float l0 = LSE[tok * 12 + hs], l1 = LSE[tok * 12 + 4 + hs], l2 = LSE[tok * 12 + 8 + hs];
            const float mx = fmaxf(l0, fmaxf(l1, l2)); float w0 = __expf(l0 - mx), w1 = __expf(l1 - mx), w2 = __expf(l2 - mx); const float inv = 1.0f / (w0 + w1 + w2); w0 *= inv; w1 *= inv; w2 *= inv;
            const size_t off = (size_t)tok * 512 + hs * 128 + ch * 8;
            const v4u o0 = *(const v4u*)(OG + off), o1 = *(const v4u*)(OG + (size_t)TH * 512 + off), o2 = *(const v4u*)(OG + (size_t)2 * TH * 512 + off);
            v4u r;
            r.x = pk2(w0 * lo_f(o0.x) + w1 * lo_f(o1.x) + w2 * lo_f(o2.x), w0 * hi_f(o0.x) + w1 * hi_f(o1.x) + w2 * hi_f(o2.x));
            r.y = pk2(w0 * lo_f(o0.y) + w1 * lo_f(o1.y) + w2 * lo_f(o2.y), w0 * hi_f(o0.y) + w1 * hi_f(o1.y) + w2 * hi_f(o2.y));
            r.z = pk2(w0 * lo_f(o0.z) + w1 * lo_f(o1.z) + w2 * lo_f(o2.z), w0 * hi_f(o0.z) + w1 * hi_f(o1.z) + w2 * hi_f(o2.z));
            r.w = pk2(w0 * lo_f(o0.w) + w1 * lo_f(o1.w) + w2 * lo_f(o2.w), w0 * hi_f(o0.w) + w1 * hi_f(o1.w) + w2 * hi_f(o2.w));
            *(v4u*)(ATT + off) = r;
        } }
        GBAR();
        { pg8::Gemm g{ATT, WattT, TH, 1024, 512}; pg8::StaticOrder S; S.init(TH, 1024, G, bx);
          EpiY1 E{P, YPRE};
          pg8::gemm_phase<EpiY1, pg8::StaticOrder, true, true>(lds, g, S, E); }
        __syncthreads();
        { pg8::Gemm g{Hb, WmlT, TH, 1024, 1024}; pg8::StaticOrder S; S.init(TH, 1024, G, bx);
          EpiYpre E{P, YPRE};
          pg8::gemm_phase<EpiYpre, pg8::StaticOrder, true, true>(lds, g, S, E); }
        GBAR();
        { pg8::Gemm g{YPRE, WoutT, TH, 1024, 1024}; pg8::StaticOrder S; S.init(TH, 1024, G, bx);
          EpiResidU2 E{x + (size_t)grow0 * 1024, out + (size_t)grow0 * 1024, ada, a.in[5], U + (size_t)grow0 * 1024, rowss + grow0, grow0};
          pg8::gemm_phase<EpiResidU2, pg8::StaticOrder, true, true>(lds, g, S, E); }
        GBAR();
        for (int rep = 0; rep < REP_FFN; ++rep)
        { pg8::Gemm g{U + (size_t)grow0 * 1024, Wff1T, TH, 4096, 1024}; pg8::StaticOrder S; S.init(TH, 4096, G, bx);
          EpiRelu2 E{HID, rowss + grow0, bias2, grow0};
          pg8::gemm_phase<EpiRelu2, pg8::StaticOrder, true, true>(lds, g, S, E); }
        GBAR();
        { pg8::Gemm g{HID, Wff2T, TH, 1024, 4096}; pg8::StaticOrder S; S.init(TH, 1024, G, bx);
          EpiResid E{out + (size_t)grow0 * 1024, out + (size_t)grow0 * 1024, ada + 5120, grow0};
          pg8::gemm_phase<EpiResid, pg8::StaticOrder, true, true>(lds, g, S, E); }
        if (hb == 0) GBAR();
    }
}

extern "C" void kernel_launch(void* const* d_in, const int* in_sizes, int n_in, void* d_out, int out_size, void* d_ws, size_t ws_size, hipStream_t stream) {
    static int grid = 0;
    if (grid == 0) {
        if (n_in != 19 || ws_size < WS_END) { fprintf(stderr, "kernel_launch: unexpected problem (n_in %d, ws %zu)\n", n_in, ws_size); grid = -1; return; }
        int dev = 0, cus = 0, per_cu = 0;
        hipGetDevice(&dev); hipDeviceGetAttribute(&cus, hipDeviceAttributeMultiprocessorCount, dev);
        if (hipFuncSetAttribute((const void*)fwd_mega, hipFuncAttributeMaxDynamicSharedMemorySize, LDS_BYTES) != hipSuccess) { fprintf(stderr, "kernel_launch: hipFuncSetAttribute failed\n"); grid = -1; return; }
        if (hipOccupancyMaxActiveBlocksPerMultiprocessor(&per_cu, (const void*)fwd_mega, 512, LDS_BYTES) != hipSuccess || per_cu < 1) { fprintf(stderr, "kernel_launch: occupancy query gave %d\n", per_cu); per_cu = 1; }
        (void)hipGetLastError();
        grid = cus * per_cu;
    }
    if (grid < 0) return;
    hipMemsetAsync((char*)d_ws + WS_ADA, 0, WS_ZERO_BYTES, stream);
    Args a{};
    for (int i = 0; i < 19; ++i) a.in[i] = (const float*)d_in[i];
    a.out = (float*)d_out; a.ws = (unsigned char*)d_ws;
    void* args[] = {&a};
    hipError_t e = hipLaunchCooperativeKernel((const void*)fwd_mega, dim3(grid), dim3(512), args, LDS_BYTES, stream);
    if (e != hipSuccess) fprintf(stderr, "cooperative launch failed: %s (grid %d)\n", hipGetErrorString(e), grid);
}
```

```cpp
#include <hip/hip_runtime.h>
#include <hip/hip_cooperative_groups.h>
#include <cstdio>
#include <cstdint>
namespace cg = cooperative_groups;
namespace pg8 {
#define PG8_LAS __attribute__((address_space(3)))
typedef unsigned short bf16_t;
typedef short bf16x8 __attribute__((ext_vector_type(8)));
typedef float f32x4 __attribute__((ext_vector_type(4)));
typedef unsigned u32x4 __attribute__((ext_vector_type(4)));
constexpr int BM = 256, BK = 64, HALF = 128, HTB = HALF * BK * 2  , STAGE_BYTES = 8 * HTB, NXCD = 8, WGM = 8;

__host__ __device__ __forceinline__ int lds_byte(int r, int c) { const int st = (r >> 4) * 2 + (c >> 5), rr = r & 15, cc = c & 31, ob = rr * 64 + cc * 2; return st * 1024 + (ob ^ (((ob >> 9) & 1) << 5)); }
__host__ __device__ __forceinline__ void stage_rc(int b, int& R, int& C) { const int st = b / 1024, sb = b % 1024, swz = sb ^ (((sb >> 9) & 1) << 5); R = (st >> 1) * 16 + swz / 64; C = (st & 1) * 32 + (swz % 64) / 2; }
__host__ __device__ __forceinline__ int perm32(int rho) { const int n = rho >> 4, i = rho & 15; return 8 * (i >> 2) + 4 * n + (i & 3); }

struct Unit { int pm, pn; };
struct Gemm { const bf16_t* A; const bf16_t* Bt; int M, N, K; };

struct StaticOrder {
    int nM, nN, nwg, G, c;
    __host__ __device__ void init(int M, int N, int G_, int c_) { nM = M / BM; nN = N / BM; nwg = nM * nN; G = G_; c = c_; }
    __host__ __device__ bool next(int i, Unit& u) const {
        const long L = (long)i * G + c; if (L >= nwg) return false;
        int wgid = (int)L; { const int q = nwg / NXCD, r = nwg % NXCD, xcd = wgid % NXCD, off = wgid / NXCD; wgid = (xcd < r ? xcd * (q + 1) : r * (q + 1) + (xcd - r) * q) + off; }
        const int nig = WGM * nN, gid = wgid / nig, fm = gid * WGM, gsz = (nM - fm) < WGM ? (nM - fm) : WGM;
        u.pm = fm + ((wgid % nig) % gsz); u.pn = (wgid % nig) / gsz; return true;
    }
    __device__ __forceinline__ void a_ready(const Unit&) const {}
    __device__ __forceinline__ void done(const Unit&) const {}
};

__device__ __forceinline__ unsigned cvt_pk_bf16(float lo, float hi) { unsigned r; asm volatile("v_cvt_pk_bf16_f32 %0, %1, %2" : "=v"(r) : "v"(lo), "v"(hi)); return r; }
typedef float f32x2 __attribute__((ext_vector_type(2)));
template <class Epi, class Sched, bool ALIGN_EPI = false, bool SP2 = false>
__device__ __forceinline__ void gemm_phase(PG8_LAS unsigned char* lds, const Gemm g, const Sched& S, const Epi& E) {
    int tid_ = threadIdx.x; asm volatile("" : "+v"(tid_));
    const int tid = tid_, wid = __builtin_amdgcn_readfirstlane(tid >> 6), lane = tid & 63, wr = wid >> 2, wc = wid & 3, fr = lane & 15, fq = lane >> 4;
    const int K = g.K, nt = K / BK;
    unsigned voffA[2], voffB[2];
#pragma unroll
    for (int i = 0; i < 2; ++i) { int R, C; stage_rc(tid * 16 + i * 8192, R, C); const int Rb = Epi::PERM ? ((R & ~31) + perm32(R & 31)) : R;
        voffA[i] = (unsigned)(R * K + C) * 2u; voffB[i] = (unsigned)(Rb * K + C) * 2u; }
    const size_t kstep = (size_t)(BK * 2);
    const size_t hstep = (size_t)HALF * K * 2;
    const size_t tstep = 2 * hstep;
    const unsigned ldsw = (unsigned)wid * 1024u;
    const int aoff = lds_byte(wr * 64 + fr, fq * 8), boff = lds_byte(wc * 32 + fr, fq * 8);
#define PG8_SA(b, h) (((b) * 2 + (h)) * HTB)
#define PG8_SB(b, h) ((4 + (b) * 2 + (h)) * HTB)
#define PG8_STAGE(bufoff, gbase, voff) do { _Pragma("unroll") for (int _i = 0; _i < 2; ++_i) \
        __builtin_amdgcn_global_load_lds((const unsigned*)((const char*)(gbase) + (voff)[_i]), (PG8_LAS unsigned*)(lds + (bufoff) + ldsw + _i * 8192), 16, 0, 0); } while (0)
#define PG8_LDA(dst, b, h) do { _Pragma("unroll") for (int m = 0; m < 4; ++m) _Pragma("unroll") for (int k = 0; k < 2; ++k) dst[m][k] = *(const PG8_LAS bf16x8*)(lds + PG8_SA(b, h) + aoff + m * 2048 + k * 1024); } while (0)
#define PG8_LDB(dst, b, h) do { _Pragma("unroll") for (int n = 0; n < 2; ++n) _Pragma("unroll") for (int k = 0; k < 2; ++k) dst[n][k] = *(const PG8_LAS bf16x8*)(lds + PG8_SB(b, h) + boff + n * 2048 + k * 1024); } while (0)
#define PG8_MMA(ai, bj, At, Bt) do { __builtin_amdgcn_s_setprio(1); _Pragma("unroll") for (int m = 0; m < 4; ++m) _Pragma("unroll") for (int n = 0; n < 2; ++n) _Pragma("unroll") for (int k = 0; k < 2; ++k) \
        acc[ai][bj][m][n] = __builtin_amdgcn_mfma_f32_16x16x32_bf16(Bt[n][k], At[m][k], acc[ai][bj][m][n], 0, 0, 0); __builtin_amdgcn_s_setprio(0); } while (0)
#define PG8_WAIT_V(n) asm volatile("s_waitcnt vmcnt(" #n ")" ::: "memory")
#define PG8_WAIT_L(n) asm volatile("s_waitcnt lgkmcnt(" #n ")" ::: "memory")
#define PG8_BAR __builtin_amdgcn_s_barrier()
#define PG8_SCHED __builtin_amdgcn_sched_barrier(0)
    Unit cur, nxt; int ui = 0;
    if (!S.next(0, cur)) return;
    f32x4 acc[2][2][4][2];
#pragma unroll
    for (int a = 0; a < 2; ++a)
#pragma unroll
        for (int b = 0; b < 2; ++b)
#pragma unroll
            for (int m = 0; m < 4; ++m)
#pragma unroll
                for (int n = 0; n < 2; ++n) acc[a][b][m][n] = (f32x4){0.f, 0.f, 0.f, 0.f};
    bf16x8 At[4][2], B0[2][2], B1[2][2];
    const char* cA = (const char*)g.A + (size_t)cur.pm * tstep; const char* cB = (const char*)g.Bt + (size_t)cur.pn * tstep;
    S.a_ready(cur);
    if constexpr (SP2) {
        PG8_STAGE(PG8_SB(0, 0), cB, voffB); PG8_STAGE(PG8_SB(0, 1), cB + hstep, voffB); PG8_STAGE(PG8_SA(0, 0), cA, voffA); PG8_STAGE(PG8_SA(0, 1), cA + hstep, voffA);
        if (wr == 1) PG8_BAR;
        PG8_WAIT_V(2); PG8_BAR;
        PG8_STAGE(PG8_SB(1, 0), cB + kstep, voffB); PG8_STAGE(PG8_SA(1, 0), cA + kstep, voffA); PG8_STAGE(PG8_SB(1, 1), cB + hstep + kstep, voffB);
        PG8_WAIT_V(6); PG8_BAR;
    } else {
        PG8_STAGE(PG8_SB(0, 0), cB, voffB); PG8_STAGE(PG8_SA(0, 0), cA, voffA); PG8_STAGE(PG8_SB(0, 1), cB + hstep, voffB); PG8_STAGE(PG8_SA(0, 1), cA + hstep, voffA);
        if (wr == 1) PG8_BAR;
        PG8_WAIT_V(4); PG8_BAR;
        PG8_STAGE(PG8_SB(1, 0), cB + kstep, voffB); PG8_STAGE(PG8_SA(1, 0), cA + kstep, voffA); PG8_STAGE(PG8_SB(1, 1), cB + hstep + kstep, voffB);
        PG8_WAIT_V(6); PG8_BAR;
    }
    for (;;) {
        const bool has_next = S.next(ui + 1, nxt);
        const char* nA = has_next ? (const char*)g.A + (size_t)nxt.pm * tstep : cA; const char* nB = has_next ? (const char*)g.Bt + (size_t)nxt.pn * tstep : cB;
        for (int t = 0; t < nt; t += 2) {
            const bool last = (t == nt - 2);
            const char* a1 = cA + (size_t)(t + 1) * kstep;
            const char* a2 = last ? nA : cA + (size_t)(t + 2) * kstep; const char* b2 = last ? nB : cB + (size_t)(t + 2) * kstep;
            const char* a3 = a2 + kstep; const char* b3 = b2 + kstep;
            if (last && has_next) S.a_ready(nxt);
            if constexpr (SP2) {
            PG8_LDB(B0, 0, 0); PG8_LDB(B1, 0, 1); PG8_SCHED; PG8_LDA(At, 0, 0); PG8_STAGE(PG8_SA(1, 1), a1 + hstep, voffA);
            PG8_WAIT_V(8); PG8_WAIT_L(0); PG8_BAR; PG8_MMA(0, 0, At, B0); PG8_MMA(0, 1, At, B1); PG8_BAR; PG8_SCHED;
            PG8_LDA(At, 0, 1); PG8_STAGE(PG8_SB(0, 0), b2, voffB); PG8_STAGE(PG8_SB(0, 1), b2 + hstep, voffB); PG8_STAGE(PG8_SA(0, 0), a2, voffA);
            PG8_WAIT_V(8); PG8_WAIT_L(0); PG8_BAR; PG8_MMA(1, 0, At, B0); PG8_MMA(1, 1, At, B1); PG8_BAR; PG8_SCHED;
            PG8_LDB(B0, 1, 0); PG8_LDB(B1, 1, 1); PG8_SCHED; PG8_LDA(At, 1, 0); PG8_STAGE(PG8_SA(0, 1), a2 + hstep, voffA);
            PG8_WAIT_V(8); PG8_WAIT_L(0); PG8_BAR; PG8_MMA(0, 0, At, B0); PG8_MMA(0, 1, At, B1); PG8_BAR; PG8_SCHED;
            PG8_LDA(At, 1, 1); PG8_STAGE(PG8_SB(1, 0), b3, voffB); PG8_STAGE(PG8_SB(1, 1), b3 + hstep, voffB); PG8_STAGE(PG8_SA(1, 0), a3, voffA);
            PG8_WAIT_V(8); PG8_WAIT_L(0); PG8_BAR; PG8_MMA(1, 0, At, B0); PG8_MMA(1, 1, At, B1); PG8_BAR; PG8_SCHED;
            } else {
            PG8_LDB(B0, 0, 0); PG8_SCHED; PG8_LDA(At, 0, 0); PG8_STAGE(PG8_SA(1, 1), a1 + hstep, voffA);
            PG8_WAIT_L(8); PG8_BAR; PG8_WAIT_L(0); PG8_MMA(0, 0, At, B0); PG8_BAR; PG8_SCHED;
            PG8_LDB(B1, 0, 1); PG8_STAGE(PG8_SB(0, 0), b2, voffB);
            PG8_BAR; PG8_WAIT_L(0); PG8_MMA(0, 1, At, B1); PG8_BAR;
            PG8_LDA(At, 0, 1); PG8_STAGE(PG8_SA(0, 0), a2, voffA);
            PG8_BAR; PG8_WAIT_L(0); PG8_MMA(1, 0, At, B0); PG8_BAR; PG8_SCHED;
            PG8_STAGE(PG8_SB(0, 1), b2 + hstep, voffB);
            PG8_WAIT_V(6); PG8_BAR; PG8_MMA(1, 1, At, B1); PG8_BAR;
            PG8_LDB(B0, 1, 0); PG8_SCHED; PG8_LDA(At, 1, 0); PG8_STAGE(PG8_SA(0, 1), a2 + hstep, voffA);
            PG8_WAIT_L(8); PG8_BAR; PG8_WAIT_L(0); PG8_MMA(0, 0, At, B0); PG8_BAR; PG8_SCHED;
            PG8_LDB(B1, 1, 1); PG8_STAGE(PG8_SB(1, 0), b3, voffB);
            PG8_BAR; PG8_WAIT_L(0); PG8_MMA(0, 1, At, B1); PG8_BAR;
            PG8_LDA(At, 1, 1); PG8_STAGE(PG8_SA(1, 0), a3, voffA);
            PG8_BAR; PG8_WAIT_L(0); PG8_MMA(1, 0, At, B0); PG8_BAR; PG8_SCHED;
            PG8_STAGE(PG8_SB(1, 1), b3 + hstep, voffB);
            PG8_WAIT_V(6); PG8_BAR; PG8_MMA(1, 1, At, B1); PG8_BAR;
            }
        }
        if constexpr (ALIGN_EPI) { if (wr == 0) PG8_BAR; }
        if constexpr (!Epi::AFTER_DRAIN) { E(acc, cur, wr, wc, fr, fq); S.done(cur); }
        if (!has_next) break;
#pragma unroll
        for (int a = 0; a < 2; ++a)
#pragma unroll
            for (int b = 0; b < 2; ++b)
#pragma unroll
                for (int m = 0; m < 4; ++m)
#pragma unroll
                    for (int n = 0; n < 2; ++n) acc[a][b][m][n] = (f32x4){0.f, 0.f, 0.f, 0.f};
        cur = nxt; cA = nA; cB = nB; ++ui;
        if constexpr (ALIGN_EPI) { if (wr == 1) PG8_BAR; }
    }
    PG8_WAIT_V(0);
    if constexpr (!ALIGN_EPI) { if (wr == 0) PG8_BAR; }
    PG8_BAR;
    if constexpr (Epi::AFTER_DRAIN) { E.fused(acc, cur, wr, wc, fr, fq, lds, wid, lane); S.done(cur); }
#undef PG8_SA
#undef PG8_SB
#undef PG8_STAGE
#undef PG8_LDA
#undef PG8_LDB
#undef PG8_MMA
#undef PG8_WAIT_V
#undef PG8_WAIT_L
#undef PG8_BAR
#undef PG8_SCHED
}
}

#define LAS __attribute__((address_space(3)))
#define DI __device__ __forceinline__
typedef unsigned short bf16;
typedef unsigned v4u __attribute__((ext_vector_type(4)));
typedef unsigned v2u __attribute__((ext_vector_type(2)));
typedef float f32x4 __attribute__((ext_vector_type(4)));
typedef float f32x16 __attribute__((ext_vector_type(16)));
typedef short bf16x8 __attribute__((ext_vector_type(8)));
typedef short v4i16_t __attribute__((ext_vector_type(4)));
#define MFMA32(a, b, c) __builtin_amdgcn_mfma_f32_32x32x16_bf16((a), (b), (c), 0, 0, 0)
#define LDS_WAIT() asm volatile("s_waitcnt lgkmcnt(0)" ::: "memory")

constexpr int T_ALL = 65536, DM = 1024, SEQ = 2048, TH = 32768, PP = 9728, NPAD = 9984, DIN = 9744;
constexpr size_t MiB = 1u << 20;
constexpr size_t WS_ADA = 0, WS_CTL = 0xC0000, WS_ROWSS = 0x100000, WS_BIAS2 = 0x140000, WS_ZERO_BYTES = 0x1C0000;
constexpr size_t WS_WIN = 2 * MiB, WS_WATT = 22 * MiB, WS_WML = 23 * MiB, WS_WOUT = 25 * MiB, WS_WFF1 = 27 * MiB, WS_WFF2 = 35 * MiB;
constexpr size_t WS_IF = 44 * MiB, WS_U = 48 * MiB, WS_P = 176 * MiB, WS_HID = 176 * MiB, WS_OG = 784 * MiB, WS_YPRE = 784 * MiB;
constexpr size_t WS_LSE = 880 * MiB, WS_H = 882 * MiB, WS_ATT = 946 * MiB, WS_END = 978 * MiB;
constexpr int LDS_BYTES = 147456;

DI size_t pidx(size_t row, int col) { return (size_t)(col >> 8) * ((size_t)TH * 256) + row * 256 + (size_t)(col & 255); }
DI float lo_f(unsigned u) { return __uint_as_float(u << 16); }
DI float hi_f(unsigned u) { return __uint_as_float(u & 0xffff0000u); }
DI float bf2f(unsigned short b) { return __uint_as_float((unsigned)b << 16); }
DI unsigned pk2(float lo, float hi) { return pg8::cvt_pk_bf16(lo, hi); }
DI int crow(int r, int h) { return (r & 3) + 8 * (r >> 2) + 4 * h; }
DI float sigmoidf_(float v) { return __builtin_amdgcn_rcpf(1.0f + __expf(-v)); }
DI float wave_sum(float v) {
#pragma unroll
    for (int o = 1; o < 64; o <<= 1) v += __shfl_xor(v, o);
    return v;
}
DI bf16x8 tr8(LAS unsigned char* plo, LAS unsigned char* phi) {
    v4i16_t a = __builtin_amdgcn_ds_read_tr16_b64_v4i16((LAS v4i16_t*)plo);
    v4i16_t b = __builtin_amdgcn_ds_read_tr16_b64_v4i16((LAS v4i16_t*)phi);
    return __builtin_shufflevector(a, b, 0, 1, 2, 3, 4, 5, 6, 7);
}
DI bf16x8 pack8(float a0, float a1, float a2, float a3, float a4, float a5, float a6, float a7) {
    v4u p; p.x = pk2(a0, a1); p.y = pk2(a2, a3); p.z = pk2(a4, a5); p.w = pk2(a6, a7);
    return __builtin_bit_cast(bf16x8, p);
}

using pg8::Unit;
struct EpiInProj {
    static constexpr bool PERM = true, AFTER_DRAIN = false;
    bf16* P; float* IFg; const float* b_if;
    DI void operator()(const f32x4 (&acc)[2][2][4][2], const Unit& u, int wr, int wc, int fr, int fq) const {
        const int row0 = u.pm * 256 + wr * 64 + fr;
        if (u.pn < 38) {
            const int col0 = u.pn * 256 + wc * 32 + 8 * fq; const bool sg = u.pn >= 26;
#pragma unroll
            for (int ai = 0; ai < 2; ++ai)
#pragma unroll
                for (int m = 0; m < 4; ++m) { bf16* rowp = P + pidx((size_t)(row0 + ai * 128 + m * 16), col0);
#pragma unroll
                    for (int bj = 0; bj < 2; ++bj) { f32x4 v0 = acc[ai][bj][m][0], v1 = acc[ai][bj][m][1];
                        if (sg) {
#pragma unroll
                            for (int i = 0; i < 4; ++i) { v0[i] = sigmoidf_(v0[i]); v1[i] = sigmoidf_(v1[i]); } }
                        v4u w; w.x = pk2(v0[0], v0[1]); w.y = pk2(v0[2], v0[3]); w.z = pk2(v1[0], v1[1]); w.w = pk2(v1[2], v1[3]);
                        __builtin_nontemporal_store(w, (v4u*)(rowp + bj * 128)); } }
        } else if (wc == 0 && fq < 2) {
            f32x4 b0 = *(const f32x4*)(b_if + 8 * fq), b1 = *(const f32x4*)(b_if + 8 * fq + 4);
#pragma unroll
            for (int ai = 0; ai < 2; ++ai)
#pragma unroll
                for (int m = 0; m < 4; ++m) { f32x4 v0 = acc[ai][0][m][0] + b0, v1 = acc[ai][0][m][1] + b1;
                    if (fq == 1) {
#pragma unroll
                        for (int i = 0; i < 4; ++i) { v0[i] = fminf(v0[i], 0.f) - __logf(1.0f + __expf(-fabsf(v0[i]))); v1[i] = fminf(v1[i], 0.f) - __logf(1.0f + __expf(-fabsf(v1[i]))); } }
                    float* o = IFg + (size_t)(row0 + ai * 128 + m * 16) * 16 + 8 * fq;
                    *(f32x4*)o = v0; *(f32x4*)(o + 4) = v1; }
        }
    }
};
struct EpiInProjMain {
    static constexpr bool PERM = true, AFTER_DRAIN = false;
    bf16* P; float* IFg; const float* b_if;
    DI void operator()(const f32x4 (&acc)[2][2][4][2], const Unit& u, int wr, int wc, int fr, int fq) const {
        const int row0 = u.pm * 256 + wr * 64 + fr;
        {
            const int col0 = u.pn * 256 + wc * 32 + 8 * fq; const bool sg = u.pn >= 26;
#pragma unroll
            for (int ai = 0; ai < 2; ++ai)
#pragma unroll
                for (int m = 0; m < 4; ++m) { bf16* rowp = P + pidx((size_t)(row0 + ai * 128 + m * 16), col0);
#pragma unroll
                    for (int bj = 0; bj < 2; ++bj) { f32x4 v0 = acc[ai][bj][m][0], v1 = acc[ai][bj][m][1];
                        if (sg) {
#pragma unroll
                            for (int i = 0; i < 4; ++i) { v0[i] = sigmoidf_(v0[i]); v1[i] = sigmoidf_(v1[i]); } }
                        v4u w; w.x = pk2(v0[0], v0[1]); w.y = pk2(v0[2], v0[3]); w.z = pk2(v1[0], v1[1]); w.w = pk2(v1[2], v1[3]);
                        __builtin_nontemporal_store(w, (v4u*)(rowp + bj * 128)); } }
        }
    }
};
template <int SIG> struct EpiProj {
    static constexpr bool PERM = true, AFTER_DRAIN = false;
    bf16* P; int ptile0;
    DI void operator()(const f32x4 (&acc)[2][2][4][2], const Unit& u, int wr, int wc, int fr, int fq) const {
        const int row0 = u.pm * 256 + wr * 64 + fr;
        bf16* base = P + (size_t)(ptile0 + u.pn) * ((size_t)TH * 256) + (size_t)row0 * 256 + wc * 32 + 8 * fq;
#pragma unroll
        for (int ai = 0; ai < 2; ++ai)
#pragma unroll
            for (int m = 0; m < 4; ++m) { bf16* rowp = base + (ai * 128 + m * 16) * 256;
#pragma unroll
                for (int bj = 0; bj < 2; ++bj) { f32x4 v0 = acc[ai][bj][m][0], v1 = acc[ai][bj][m][1];
                    if (SIG) {
#pragma unroll
                        for (int i = 0; i < 4; ++i) { v0[i] = sigmoidf_(v0[i]); v1[i] = sigmoidf_(v1[i]); } }
                    v4u w; w.x = pk2(v0[0], v0[1]); w.y = pk2(v0[2], v0[3]); w.z = pk2(v1[0], v1[1]); w.w = pk2(v1[2], v1[3]);
                    __builtin_nontemporal_store(w, (v4u*)(rowp + bj * 128)); } }
    }
};
struct EpiIF {
    static constexpr bool PERM = true, AFTER_DRAIN = false;
    float* IFg; const float* b_if;
    DI void operator()(const f32x4 (&acc)[2][2][4][2], const Unit& u, int wr, int wc, int fr, int fq) const {
        const int row0 = u.pm * 256 + wr * 64 + fr;
        if (wc == 0 && fq < 2) {
            f32x4 b0 = *(const f32x4*)(b_if + 8 * fq), b1 = *(const f32x4*)(b_if + 8 * fq + 4);
#pragma unroll
            for (int ai = 0; ai < 2; ++ai)
#pragma unroll
                for (int m = 0; m < 4; ++m) { f32x4 v0 = acc[ai][0][m][0] + b0, v1 = acc[ai][0][m][1] + b1;
                    if (fq == 1) {
#pragma unroll
                        for (int i = 0; i < 4; ++i) { v0[i] = fminf(v0[i], 0.f) - __builtin_amdgcn_logf(1.0f + __expf(-fabsf(v0[i]))) * 0.6931471805599453f; v1[i] = fminf(v1[i], 0.f) - __builtin_amdgcn_logf(1.0f + __expf(-fabsf(v1[i]))) * 0.6931471805599453f; } }
                    float* o = IFg + (size_t)(row0 + ai * 128 + m * 16) * 16 + 8 * fq;
                    *(f32x4*)o = v0; *(f32x4*)(o + 4) = v1; }
        }
    }
};
struct EpiY1 {
    static constexpr bool PERM = true, AFTER_DRAIN = false;
    const bf16* P; bf16* Y;
    DI void operator()(const f32x4 (&acc)[2][2][4][2], const Unit& u, int wr, int wc, int fr, int fq) const {
        const int row0 = u.pm * 256 + wr * 64 + fr, col0 = u.pn * 256 + wc * 32 + 8 * fq;
#pragma unroll
        for (int ai = 0; ai < 2; ++ai)
#pragma unroll
            for (int m = 0; m < 4; ++m) { const size_t r = (size_t)(row0 + ai * 128 + m * 16);
#pragma unroll
                for (int bj = 0; bj < 2; ++bj) { const int c = col0 + bj * 128; const v4u g = *(const v4u*)(P + pidx(r, 7680 + c));
                    const f32x4 v0 = acc[ai][bj][m][0], v1 = acc[ai][bj][m][1];
                    v4u w; w.x = pk2(v0[0] * lo_f(g.x), v0[1] * hi_f(g.x)); w.y = pk2(v0[2] * lo_f(g.y), v0[3] * hi_f(g.y)); w.z = pk2(v1[0] * lo_f(g.z), v1[1] * hi_f(g.z)); w.w = pk2(v1[2] * lo_f(g.w), v1[3] * hi_f(g.w));
                    *(v4u*)(Y + r * 1024 + c) = w; } }
    }
};
struct EpiYpre {
    static constexpr bool PERM = true, AFTER_DRAIN = false;
    const bf16* P; bf16* Y;
    DI void operator()(const f32x4 (&acc)[2][2][4][2], const Unit& u, int wr, int wc, int fr, int fq) const {
        const int row0 = u.pm * 256 + wr * 64 + fr, col0 = u.pn * 256 + wc * 32 + 8 * fq;
#pragma unroll
        for (int ai = 0; ai < 2; ++ai)
#pragma unroll
            for (int m = 0; m < 4; ++m) { const size_t r = (size_t)(row0 + ai * 128 + m * 16);
#pragma unroll
                for (int bj = 0; bj < 2; ++bj) { const int c = col0 + bj * 128; const v4u g = *(const v4u*)(P + pidx(r, 8704 + c)); const v4u y = *(const v4u*)(Y + r * 1024 + c);
                    const f32x4 a0 = acc[ai][bj][m][0], a1 = acc[ai][bj][m][1];
                    v4u w; w.x = pk2(lo_f(y.x) + a0[0] * lo_f(g.x), hi_f(y.x) + a0[1] * hi_f(g.x)); w.y = pk2(lo_f(y.y) + a0[2] * lo_f(g.y), hi_f(y.y) + a0[3] * hi_f(g.y));
                    w.z = pk2(lo_f(y.z) + a1[0] * lo_f(g.z), hi_f(y.z) + a1[1] * hi_f(g.z)); w.w = pk2(lo_f(y.w) + a1[2] * lo_f(g.w), hi_f(y.w) + a1[3] * hi_f(g.w));
                    *(v4u*)(Y + r * 1024 + c) = w; } }
    }
};
struct EpiResid {
    static constexpr bool PERM = true, AFTER_DRAIN = false;
    const float* base; float* out; const float* gate; int grow0;
    DI void operator()(const f32x4 (&acc)[2][2][4][2], const Unit& u, int wr, int wc, int fr, int fq) const {
        const int row0 = u.pm * 256 + wr * 64 + fr, col0 = u.pn * 256 + wc * 32 + 8 * fq;
        const int b = (grow0 + u.pm * 256) >> 11;
        f32x4 g[2][2];
#pragma unroll
        for (int bj = 0; bj < 2; ++bj) { const float* gp = gate + (size_t)b * 6144 + col0 + bj * 128; g[bj][0] = *(const f32x4*)gp; g[bj][1] = *(const f32x4*)(gp + 4); }
#pragma unroll
        for (int ai = 0; ai < 2; ++ai)
#pragma unroll
            for (int m = 0; m < 4; ++m) { const size_t r = (size_t)(row0 + ai * 128 + m * 16);
#pragma unroll
                for (int bj = 0; bj < 2; ++bj) { const size_t off = r * 1024 + col0 + bj * 128;
                    f32x4 v0 = *(const f32x4*)(base + off), v1 = *(const f32x4*)(base + off + 4);
                    v0 += g[bj][0] * acc[ai][bj][m][0]; v1 += g[bj][1] * acc[ai][bj][m][1];
                    *(f32x4*)(out + off) = v0; *(f32x4*)(out + off + 4) = v1; } }
    }
};
struct EpiResidU2 {
    static constexpr bool PERM = true, AFTER_DRAIN = false;
    const float* base; float* out; const float* ada; const float* g2; bf16* U2; float* rowss; int grow0;
    DI void operator()(const f32x4 (&acc)[2][2][4][2], const Unit& u, int wr, int wc, int fr, int fq) const {
        const int row0 = u.pm * 256 + wr * 64 + fr, col0 = u.pn * 256 + wc * 32 + 8 * fq;
        const int b = (grow0 + u.pm * 256) >> 11;
        f32x4 g[2][2], gm[2][2];
#pragma unroll
        for (int bj = 0; bj < 2; ++bj) { const int c = col0 + bj * 128; const float* gp = ada + (size_t)b * 6144 + 2048 + c; const float* sp = ada + (size_t)b * 6144 + 4096 + c;
            g[bj][0] = *(const f32x4*)gp; g[bj][1] = *(const f32x4*)(gp + 4);
            gm[bj][0] = *(const f32x4*)(g2 + c) * (*(const f32x4*)sp + 1.0f); gm[bj][1] = *(const f32x4*)(g2 + c + 4) * (*(const f32x4*)(sp + 4) + 1.0f); }
#pragma unroll
        for (int ai = 0; ai < 2; ++ai)
#pragma unroll
            for (int m = 0; m < 4; ++m) { const size_t r = (size_t)(row0 + ai * 128 + m * 16); float ss = 0.f;
#pragma unroll
                for (int bj = 0; bj < 2; ++bj) { const size_t off = r * 1024 + col0 + bj * 128;
                    f32x4 v0 = *(const f32x4*)(base + off), v1 = *(const f32x4*)(base + off + 4);
                    v0 += g[bj][0] * acc[ai][bj][m][0]; v1 += g[bj][1] * acc[ai][bj][m][1];
                    *(f32x4*)(out + off) = v0; *(f32x4*)(out + off + 4) = v1;
                    ss += (v0[0] * v0[0] + v0[1] * v0[1]) + (v0[2] * v0[2] + v0[3] * v0[3]) + (v1[0] * v1[0] + v1[1] * v1[1]) + (v1[2] * v1[2] + v1[3] * v1[3]);
                    const f32x4 u0 = v0 * gm[bj][0], u1 = v1 * gm[bj][1];
                    v4u w; w.x = pk2(u0[0], u0[1]); w.y = pk2(u0[2], u0[3]); w.z = pk2(u1[0], u1[1]); w.w = pk2(u1[2], u1[3]);
                    *(v4u*)(U2 + off) = w; }
                ss += __shfl_xor(ss, 16); ss += __shfl_xor(ss, 32);
                if (fq == 0) atomicAdd(rowss + r, ss); }
    }
};
struct EpiRelu2 {
    static constexpr bool PERM = true, AFTER_DRAIN = false;
    bf16* O; const float* rowss; const float* bias2; int grow0;
    DI void operator()(const f32x4 (&acc)[2][2][4][2], const Unit& u, int wr, int wc, int fr, int fq) const {
        const int row0 = u.pm * 256 + wr * 64 + fr, col0 = u.pn * 256 + wc * 32 + 8 * fq;
        const int bb = (grow0 + u.pm * 256) >> 11;
        f32x4 bs[2][2];
#pragma unroll
        for (int bj = 0; bj < 2; ++bj) { const float* bp = bias2 + (size_t)bb * 4096 + col0 + bj * 128; bs[bj][0] = *(const f32x4*)bp; bs[bj][1] = *(const f32x4*)(bp + 4); }
#pragma unroll
        for (int ai = 0; ai < 2; ++ai)
#pragma unroll
            for (int m = 0; m < 4; ++m) { bf16* rowp = O + (size_t)(row0 + ai * 128 + m * 16) * 4096 + col0;
                const float rstd = rsqrtf(rowss[row0 + ai * 128 + m * 16] * (1.0f / 1024.0f) + 1e-6f);
#pragma unroll
                for (int bj = 0; bj < 2; ++bj) { f32x4 v0 = acc[ai][bj][m][0] * rstd + bs[bj][0], v1 = acc[ai][bj][m][1] * rstd + bs[bj][1];
#pragma unroll
                    for (int i = 0; i < 4; ++i) { float a = fmaxf(v0[i], 0.f), b = fmaxf(v1[i], 0.f); v0[i] = a * a; v1[i] = b * b; }
                    v4u w; w.x = pk2(v0[0], v0[1]); w.y = pk2(v0[2], v0[3]); w.z = pk2(v1[0], v1[1]); w.w = pk2(v1[2], v1[3]);
                    *(v4u*)(rowp + bj * 128) = w; } }
    }
};

DI void transpose_item(const float* W, int ldw, int n0src, bf16* WT, int K, int row0dst, LAS float* scr, int kb, int lane) {
    const int k0 = 64 * kb;
#pragma unroll 8
    for (int i = 0; i < 32; ++i) { const int kk = 2 * i + (lane >> 5); scr[kk * 33 + (lane & 31)] = W[(size_t)(k0 + kk) * ldw + n0src + (lane & 31)]; }
    LDS_WAIT(); asm volatile("" ::: "memory");
    const int c = lane & 7;
#pragma unroll
    for (int j = 0; j < 4; ++j) { const int n = (lane >> 3) + 8 * j; const LAS float* s = scr + (8 * c) * 33 + n;
        v4u o; o.x = pk2(s[0 * 33], s[1 * 33]); o.y = pk2(s[2 * 33], s[3 * 33]); o.z = pk2(s[4 * 33], s[5 * 33]); o.w = pk2(s[6 * 33], s[7 * 33]);
        *(v4u*)(WT + (size_t)(row0dst + n) * K + k0 + 8 * c) = o; }
    LDS_WAIT(); asm volatile("" ::: "memory");
}
DI void wseg(const float* W, int ldw, int K, int ncb, int src0, int dst0, bf16* WT, LAS float* scr, int item, int lane) {
    const int kb = item / ncb, nb = item % ncb;
    transpose_item(W, ldw, src0 + 32 * nb, WT, K, dst0 + 32 * nb, scr, kb, lane);
}
DI void ada_item(const float* c, const float* wada, const float* bada, float* ada, LAS float* scr, int item, int lane) {
    const int cb = item % 96, kc = item / 96;
#pragma unroll 4
    for (int i = 0; i < 64; ++i) { const int idx = i * 64 + lane, k = idx >> 5, b = idx & 31; const float v = c[b * 1024 + kc * 128 + k]; scr[idx] = v * sigmoidf_(v); }
    LDS_WAIT(); asm volatile("" ::: "memory");
    float acc[32];
#pragma unroll
    for (int b = 0; b < 32; ++b) acc[b] = 0.f;
    const float* wp = wada + (size_t)(kc * 128) * 6144 + cb * 64 + lane;
#pragma unroll 2
    for (int k = 0; k < 128; ++k) { const float w = wp[(size_t)k * 6144];
#pragma unroll
        for (int b4 = 0; b4 < 8; ++b4) { const f32x4 sv = *(const LAS f32x4*)(scr + k * 32 + b4 * 4);
            acc[4 * b4] += sv[0] * w; acc[4 * b4 + 1] += sv[1] * w; acc[4 * b4 + 2] += sv[2] * w; acc[4 * b4 + 3] += sv[3] * w; } }
    const int col = cb * 64 + lane; const float bias = (kc == 0) ? bada[col] : 0.f;
#pragma unroll
    for (int b = 0; b < 32; ++b) atomicAdd(ada + b * 6144 + col, acc[b] + bias);
    LDS_WAIT(); asm volatile("" ::: "memory");
}
DI void bias2_item(const float* ada, const float* w1, float* bias2, LAS float* scr, int item, int lane) {
    const int cb = item % 64, kc = item / 64;
#pragma unroll 4
    for (int i = 0; i < 64; ++i) { const int idx = i * 64 + lane, k = idx >> 5, b = idx & 31; scr[idx] = ada[(size_t)b * 6144 + 3072 + kc * 128 + k]; }
    LDS_WAIT(); asm volatile("" ::: "memory");
    float acc[32];
#pragma unroll
    for (int b = 0; b < 32; ++b) acc[b] = 0.f;
    const float* wp = w1 + (size_t)(kc * 128) * 4096 + cb * 64 + lane;
#pragma unroll 2
    for (int k = 0; k < 128; ++k) { const float w = wp[(size_t)k * 4096];
#pragma unroll
        for (int b4 = 0; b4 < 8; ++b4) { const f32x4 sv = *(const LAS f32x4*)(scr + k * 32 + b4 * 4);
            acc[4 * b4] += sv[0] * w; acc[4 * b4 + 1] += sv[1] * w; acc[4 * b4 + 2] += sv[2] * w; acc[4 * b4 + 3] += sv[3] * w; } }
    const int col = cb * 64 + lane;
#pragma unroll
    for (int b = 0; b < 32; ++b) atomicAdd(bias2 + b * 4096 + col, acc[b]);
    LDS_WAIT(); asm volatile("" ::: "memory");
}
DI void if_rows(const bf16* Uh, const bf16* Wif, float* IFh, const float* b_if, int item, int lane) {
    const int r32 = lane & 31, h = lane >> 5;
    const bf16* ap = Uh + (size_t)(32 * item + r32) * 1024 + 8 * h; const bf16* bp = Wif + (size_t)r32 * 1024 + 8 * h;
    f32x16 acc;
#pragma unroll
    for (int i = 0; i < 16; ++i) acc[i] = 0.f;
#pragma unroll 8
    for (int kk = 0; kk < 64; ++kk) { const bf16x8 av = *(const bf16x8*)(ap + 16 * kk), bv = *(const bf16x8*)(bp + 16 * kk); acc = MFMA32(av, bv, acc); }
    if (r32 < 16) { const float bias = b_if[r32];
#pragma unroll
        for (int r = 0; r < 16; ++r) { float v = acc[r] + bias;
            if (r32 >= 8) v = fminf(v, 0.f) - __builtin_amdgcn_logf(1.0f + __expf(-fabsf(v))) * 0.6931471805599453f;
            IFh[(size_t)(32 * item + crow(r, h)) * 16 + r32] = v; } }
}
DI void prenorm_rows(const float* X, const float* gvec, const float* ada, int sh_off, int sc_off, bf16* U, int row_lo, int row_hi, int gw, int ngw, int lane) {
    const int nrows = row_hi - row_lo, rpw = (nrows + ngw - 1) / ngw; const int m0 = row_lo + gw * rpw; int m1 = m0 + rpw; if (m1 > row_hi) m1 = row_hi;
    int curb = -1; f32x4 mul[4], add[4], nx[4];
    if (m0 < m1) {
#pragma unroll
        for (int j = 0; j < 4; ++j) nx[j] = *(const f32x4*)(X + (size_t)m0 * 1024 + 4 * lane + 256 * j);
    }
    for (int m = m0; m < m1; ++m) {
        const int b = m >> 11;
        f32x4 v[4]; float ss = 0.f;
#pragma unroll
        for (int j = 0; j < 4; ++j) v[j] = nx[j];
        if (m + 1 < m1) {
#pragma unroll
            for (int j = 0; j < 4; ++j) nx[j] = *(const f32x4*)(X + (size_t)(m + 1) * 1024 + 4 * lane + 256 * j);
        }
        if (b != curb) { curb = b;
#pragma unroll
            for (int j = 0; j < 4; ++j) { const int col = 4 * lane + 256 * j; const f32x4 g = *(const f32x4*)(gvec + col), sc = *(const f32x4*)(ada + (size_t)b * 6144 + sc_off + col);
                mul[j] = g * (sc + 1.0f); add[j] = *(const f32x4*)(ada + (size_t)b * 6144 + sh_off + col); } }
#pragma unroll
        for (int j = 0; j < 4; ++j) ss += (v[j][0] * v[j][0] + v[j][1] * v[j][1]) + (v[j][2] * v[j][2] + v[j][3] * v[j][3]);
        const float rstd = rsqrtf(wave_sum(ss) * (1.0f / 1024.0f) + 1e-6f);
#pragma unroll
        for (int j = 0; j < 4; ++j) { const f32x4 o = (v[j] * rstd) * mul[j] + add[j]; v2u w; w.x = pk2(o[0], o[1]); w.y = pk2(o[2], o[3]);
            *(v2u*)(U + (size_t)m * 1024 + 4 * lane + 256 * j) = w; }
    }
}
constexpr int M_Q = 0, M_K = 9216, M_K2 = 18432, M_V = 30720, M_C = 51200, M_GATE = 71680, M_NPART = 73216, M_SSQ = 75264, M_NVEC = 76288, M_CW = 76544, M_MLG = 79104, M_SLOT = 79616;
DI void mlstm_seq(LAS unsigned char* lds, const bf16* P, const float* IFg, bf16* Hout, const float* conv_w, const float* conv_b, const float* mlg, int seq) {
    int tid_ = threadIdx.x; asm volatile("" : "+v"(tid_));
    const int tid = tid_, wv = __builtin_amdgcn_readfirstlane(tid >> 6), lane = tid & 63, r32 = lane & 31, hh = lane >> 5;
    const int dvs = wv & 3, th = wv >> 2, i16 = lane & 15, q4 = i16 >> 2, p4 = i16 & 3, gg = (lane >> 4) & 1;
    const int bl = seq >> 3, hd = seq & 7; const size_t rowb = (size_t)bl * 2048;
    LAS unsigned char* Qt = lds + M_Q; LAS unsigned char* Kt = lds + M_K; LAS unsigned char* Kt2 = lds + M_K2; LAS unsigned char* Vt = lds + M_V; LAS unsigned char* Cimg = lds + M_C;
    LAS float* gate = (LAS float*)(lds + M_GATE); LAS float* npart = (LAS float*)(lds + M_NPART); LAS float* ssq = (LAS float*)(lds + M_SSQ); LAS float* nvec = (LAS float*)(lds + M_NVEC);
    const int isk = (tid >> 8) & 1, cgp = (tid >> 5) & 7, rg = tid & 31;
    const int chb = isk * 512 + hd * 64 + 8 * cgp, lch = isk * 64 + 8 * cgp;
    f32x16 Cst;
#pragma unroll
    for (int i = 0; i < 16; ++i) Cst[i] = 0.f;
    float n_reg = 0.f, m_run = 0.f;
    for (int i = tid; i < 1280; i += 512) *(LAS v4u*)(Cimg + 16 * i) = (v4u){0u, 0u, 0u, 0u};
    if (tid < 64) nvec[tid] = 0.f;
    LAS float* cw = (LAS float*)(lds + M_CW); LAS float* mlgl = (LAS float*)(lds + M_MLG);
    for (int i = tid; i < 640; i += 512) { const int j = i >> 7, ch = i & 127, gch = (ch >> 6) * 512 + hd * 64 + (ch & 63); cw[i] = (j < 4) ? conv_w[j * 1024 + gch] : conv_b[gch]; }
    if (tid < 128) mlgl[tid] = mlg[hd * 128 + tid];
    __syncthreads();
    v4u qk[5], vv[2]; float pli = 0.f, plf = 0.f;
#define ML_LOAD(c_) do { const int t0_ = 64 * (c_); \
        { _Pragma("unroll") for (int i = 0; i < 5; ++i) { const int t_ = t0_ + 2 * rg - 3 + i; \
            qk[i] = (t_ >= 0) ? *(const v4u*)(P + pidx(rowb + t_, 4608 + chb)) : (v4u){0u, 0u, 0u, 0u}; } } \
        _Pragma("unroll") for (int i = 0; i < 2; ++i) { const int idx_ = tid + 512 * i, s_ = idx_ >> 4, ch_ = idx_ & 15; \
            vv[i] = *(const v4u*)(P + pidx(rowb + t0_ + s_, 5632 + hd * 128 + 8 * ch_)); } \
        if (wv == 0) { const size_t r_ = (rowb + t0_ + lane) * 16; pli = IFg[r_ + hd]; plf = IFg[r_ + 8 + hd]; } } while (0)
#define ML_WRITE() do { \
        { float wj[4][8], bs[8]; \
            _Pragma("unroll") for (int j = 0; j < 4; ++j) { const f32x4 a_ = *(const LAS f32x4*)(cw + j * 128 + lch), b_ = *(const LAS f32x4*)(cw + j * 128 + lch + 4); \
                wj[j][0] = a_[0]; wj[j][1] = a_[1]; wj[j][2] = a_[2]; wj[j][3] = a_[3]; wj[j][4] = b_[0]; wj[j][5] = b_[1]; wj[j][6] = b_[2]; wj[j][7] = b_[3]; } \
            { const f32x4 a_ = *(const LAS f32x4*)(cw + 512 + lch), b_ = *(const LAS f32x4*)(cw + 512 + lch + 4); bs[0] = a_[0]; bs[1] = a_[1]; bs[2] = a_[2]; bs[3] = a_[3]; bs[4] = b_[0]; bs[5] = b_[1]; bs[6] = b_[2]; bs[7] = b_[3]; } \
            _Pragma("unroll") for (int rr = 0; rr < 2; ++rr) { float y_[8]; \
                _Pragma("unroll") for (int e = 0; e < 8; ++e) y_[e] = bs[e]; \
                _Pragma("unroll") for (int j = 0; j < 4; ++j) { const v4u x_ = *(const LAS v4u*)(slot + (rr + j) * 8192); \
                    y_[0] += wj[j][0] * lo_f(x_.x); y_[1] += wj[j][1] * hi_f(x_.x); y_[2] += wj[j][2] * lo_f(x_.y); y_[3] += wj[j][3] * hi_f(x_.y); \
                    y_[4] += wj[j][4] * lo_f(x_.z); y_[5] += wj[j][5] * hi_f(x_.z); y_[6] += wj[j][6] * lo_f(x_.w); y_[7] += wj[j][7] * hi_f(x_.w); } \
                _Pragma("unroll") for (int e = 0; e < 8; ++e) { y_[e] = y_[e] * sigmoidf_(y_[e]); if (isk) y_[e] *= 0.125f; } \
                v4u o_; o_.x = pk2(y_[0], y_[1]); o_.y = pk2(y_[2], y_[3]); o_.z = pk2(y_[4], y_[5]); o_.w = pk2(y_[6], y_[7]); \
                const int s_ = 2 * rg + rr; \
                if (!isk) *(LAS v4u*)(Qt + s_ * 144 + 16 * cgp) = o_; else { *(LAS v4u*)(Kt + s_ * 144 + 16 * cgp) = o_; *(LAS v4u*)(Kt2 + s_ * 192 + 16 * cgp) = o_; } } } \
        _Pragma("unroll") for (int i = 0; i < 2; ++i) { const int idx_ = tid + 512 * i, s_ = idx_ >> 4, ch_ = idx_ & 15; *(LAS v4u*)(Vt + s_ * 320 + 16 * ch_) = *(const LAS v4u*)(slot + (5 + i) * 8192); } \
        ML_GSTORE(); } while (0)
#define ML_GCOMP() do { if (wv == 0) { float b_ = plf2; \
            _Pragma("unroll") for (int o = 1; o < 64; o <<= 1) { const float v_ = __shfl_up(b_, o); if (lane >= o) b_ += v_; } \
            const float d_ = pli2 - b_; float cm_ = d_; \
            _Pragma("unroll") for (int o = 1; o < 64; o <<= 1) { const float v_ = __shfl_up(cm_, o); if (lane >= o) cm_ = fmaxf(cm_, v_); } \
            const float M_ = fmaxf(m_run, cm_); const float bend_ = __shfl(b_, 63), M63_ = __shfl(M_, 63); \
            g_d = d_; g_M = M_; g_i = __expf(m_run - M_); g_e = __expf(-(b_ + M_)); g_w = __expf(d_ - M63_); g_dec = __expf(m_run - M63_); \
            m_run = bend_ + M63_; } } while (0)
#define ML_GSTORE() do { if (wv == 0) { gate[lane] = g_d; gate[64 + lane] = g_M; gate[128 + lane] = g_i; gate[192 + lane] = g_e; gate[256 + lane] = g_w; if (lane == 0) gate[320] = g_dec; } } while (0)
    float g_d = 0.f, g_M = 0.f, g_i = 0.f, g_e = 0.f, g_w = 0.f, g_dec = 0.f;

    LAS unsigned char* slot = lds + M_SLOT + tid * 16; float pli2 = 0.f, plf2 = 0.f;
#define ML_PARK() do { _Pragma("unroll") for (int i = 0; i < 5; ++i) *(LAS v4u*)(slot + i * 8192) = qk[i]; *(LAS v4u*)(slot + 5 * 8192) = vv[0]; *(LAS v4u*)(slot + 6 * 8192) = vv[1]; pli2 = pli; plf2 = plf; } while (0)
    ML_LOAD(0);
    ML_PARK();
    ML_GCOMP();
    ML_WRITE();
    ML_LOAD(1);
    for (int c = 0; c < 32; ++c) {
        __syncthreads();
        if (c < 31) ML_PARK();
        if (c < 30) ML_LOAD(c + 2);
        if (c < 31) ML_GCOMP();
        const int t = 32 * th + r32; const size_t row = rowb + 64 * c + t;
        v2u og[4];
#pragma unroll
        for (int rq = 0; rq < 4; ++rq) og[rq] = *(const v2u*)(P + pidx(row, 6656 + hd * 128 + 32 * dvs + 8 * rq + 4 * hh));
        const float Mt = gate[64 + t], it = gate[128 + t], et = gate[192 + t], dec = gate[320];
        bf16x8 qf[4];
#pragma unroll
        for (int kk = 0; kk < 4; ++kk) qf[kk] = *(const LAS bf16x8*)(Qt + t * 144 + 32 * kk + 16 * hh);
        f32x16 sacc[2];
#pragma unroll
        for (int st = 0; st < 2; ++st) {
#pragma unroll
            for (int i = 0; i < 16; ++i) sacc[st][i] = 0.f;
            if (st <= th) {
#pragma unroll
                for (int kk = 0; kk < 4; ++kk) { const bf16x8 a = *(const LAS bf16x8*)(Kt + (32 * st + r32) * 144 + 32 * kk + 16 * hh); sacc[st] = MFMA32(a, qf[kk], sacc[st]); } }
        }
        float rowsum = 0.f; bf16x8 Wf[4];
#pragma unroll
        for (int st = 0; st < 2; ++st) {
            if (st <= th) {
#pragma unroll
            for (int rq = 0; rq < 4; ++rq) { const f32x4 d4 = *(const LAS f32x4*)(gate + 32 * st + 8 * rq + 4 * hh);
#pragma unroll
                for (int i = 0; i < 4; ++i) { const int s = 32 * st + 8 * rq + 4 * hh + i; const float e = __expf(d4[i] - Mt); const float w = (s <= t) ? sacc[st][4 * rq + i] * e : 0.f; rowsum += w; sacc[st][4 * rq + i] = w; } } }
            Wf[2 * st] = pack8(sacc[st][0], sacc[st][1], sacc[st][2], sacc[st][3], sacc[st][4], sacc[st][5], sacc[st][6], sacc[st][7]);
            Wf[2 * st + 1] = pack8(sacc[st][8], sacc[st][9], sacc[st][10], sacc[st][11], sacc[st][12], sacc[st][13], sacc[st][14], sacc[st][15]);
        }
        float qn = 0.f;
#pragma unroll
        for (int kk = 0; kk < 4; ++kk) { const f32x4 n0 = *(const LAS f32x4*)(nvec + 16 * kk + 8 * hh), n1 = *(const LAS f32x4*)(nvec + 16 * kk + 8 * hh + 4); const v4u q = __builtin_bit_cast(v4u, qf[kk]);
            qn += lo_f(q.x) * n0[0] + hi_f(q.x) * n0[1] + lo_f(q.y) * n0[2] + hi_f(q.y) * n0[3] + lo_f(q.z) * n1[0] + hi_f(q.z) * n1[1] + lo_f(q.w) * n1[2] + hi_f(q.w) * n1[3]; }
        qn += __shfl_xor(qn, 32); rowsum += __shfl_xor(rowsum, 32);
        const float nq = rowsum + it * qn; const float invd = 1.0f / fmaxf(fabsf(nq), et);
        bf16x8 vf[4];
#pragma unroll
        for (int k4 = 0; k4 < 4; ++k4) { LAS unsigned char* p = Vt + (16 * k4 + 4 * hh + q4) * 320 + 2 * (32 * dvs + 16 * gg + 4 * p4); vf[k4] = tr8(p, p + 8 * 320); }
        f32x16 num, qc;
#pragma unroll
        for (int i = 0; i < 16; ++i) { num[i] = 0.f; qc[i] = 0.f; }
#pragma unroll
        for (int k4 = 0; k4 < 4; ++k4) if (k4 < 2 * (th + 1)) num = MFMA32(vf[k4], Wf[k4], num);
#pragma unroll
        for (int kk = 0; kk < 4; ++kk) { LAS unsigned char* p = Cimg + (16 * kk + 8 * hh + q4) * 320 + 2 * (32 * dvs + 16 * gg + 4 * p4); const bf16x8 cf = tr8(p, p + 4 * 320); qc = MFMA32(cf, qf[kk], qc); }
        float hv[16]; float ss = 0.f;
#pragma unroll
        for (int i = 0; i < 16; ++i) { hv[i] = (num[i] + it * qc[i]) * invd; ss += hv[i] * hv[i]; }
        ss += __shfl_xor(ss, 32);
        if (hh == 0) ssq[dvs * 64 + t] = ss;
#pragma unroll
        for (int i = 0; i < 16; ++i) Cst[i] *= dec;
#pragma unroll
        for (int k4 = 0; k4 < 4; ++k4) { const f32x4 wa = *(const LAS f32x4*)(gate + 256 + 16 * k4 + 4 * hh), wb = *(const LAS f32x4*)(gate + 256 + 16 * k4 + 8 + 4 * hh);
            LAS unsigned char* p = Kt2 + (16 * k4 + 4 * hh + q4) * 192 + 2 * (32 * th + 16 * gg + 4 * p4); const v4u kq = __builtin_bit_cast(v4u, tr8(p, p + 8 * 192));
            const bf16x8 kf2 = pack8(lo_f(kq.x) * wa[0], hi_f(kq.x) * wa[1], lo_f(kq.y) * wa[2], hi_f(kq.y) * wa[3], lo_f(kq.z) * wb[0], hi_f(kq.z) * wb[1], lo_f(kq.w) * wb[2], hi_f(kq.w) * wb[3]);
            Cst = MFMA32(vf[k4], kf2, Cst); }
        { float np = 0.f;
#pragma unroll
            for (int i = 0; i < 8; ++i) { const int s = 8 * wv + i; np += gate[256 + s] * bf2f(*(const LAS unsigned short*)(Kt + s * 144 + 2 * lane)); }
            npart[wv * 64 + lane] = np; }
        __syncthreads();
        const float tot = ssq[t] + ssq[64 + t] + ssq[128 + t] + ssq[192 + t]; const float rstd = rsqrtf(tot * (1.0f / 128.0f) + 1e-6f);
#pragma unroll
        for (int rq = 0; rq < 4; ++rq) { const int dv = 32 * dvs + 8 * rq + 4 * hh; const f32x4 gl = *(const LAS f32x4*)(mlgl + dv);
            const float o0 = hv[4 * rq] * rstd * gl[0] * lo_f(og[rq].x), o1 = hv[4 * rq + 1] * rstd * gl[1] * hi_f(og[rq].x), o2 = hv[4 * rq + 2] * rstd * gl[2] * lo_f(og[rq].y), o3 = hv[4 * rq + 3] * rstd * gl[3] * hi_f(og[rq].y);
            v2u w; w.x = pk2(o0, o1); w.y = pk2(o2, o3); *(v2u*)(Hout + row * 1024 + hd * 128 + dv) = w;
            v2u cw; cw.x = pk2(Cst[4 * rq], Cst[4 * rq + 1]); cw.y = pk2(Cst[4 * rq + 2], Cst[4 * rq + 3]);
            *(LAS v2u*)(Cimg + (32 * th + r32) * 320 + 2 * dv) = cw; }
        if (wv == 5) { float s = 0.f;
#pragma unroll
            for (int w = 0; w < 8; ++w) s += npart[w * 64 + lane];
            n_reg = dec * n_reg + s; nvec[lane] = n_reg; }
        if (c < 31) ML_WRITE();
    }
#undef ML_LOAD
#undef ML_PARK
#undef ML_GCOMP
#undef ML_GSTORE
#undef ML_WRITE
    __syncthreads();
}

constexpr int A_HALF = 39168, A_K = 0, A_V = 17408, A_BIAS = 37888, A_GQ = 78336, A_GK = 78848, A_UNIT = 79360;
DI void attn_unit(LAS unsigned char* lds, const bf16* P, bf16* OG, float* LSE, const float* relb, int u) {
    int tid_ = threadIdx.x; asm volatile("" : "+v"(tid_));
    const int tid = tid_, hw = __builtin_amdgcn_readfirstlane(tid >> 8), htid = tid & 255, w = __builtin_amdgcn_readfirstlane((tid >> 6) & 3), lane = tid & 63, r32 = lane & 31, hh = lane >> 5;
    const int i16 = lane & 15, q4 = i16 >> 2, p4 = i16 & 3, gg = (lane >> 4) & 1;
    const int bp = u & 7, t2 = u >> 3, head = t2 % 12, bl = t2 / 12, g = head >> 2, hs = head & 3;
    const int dil = (g == 0) ? 1 : ((g == 1) ? 4 : 16), nbs = (g == 0) ? 4 : ((g == 1) ? 2 : 0);
    const int blk = 2 * bp + hw, r = blk >> nbs, qb = blk & ((1 << nbs) - 1);
    const size_t rowb = (size_t)bl * 2048;
    LAS unsigned char* Kl = lds + hw * A_HALF + A_K; LAS unsigned char* Vl = lds + hw * A_HALF + A_V; LAS float* biasT = (LAS float*)(lds + hw * A_HALF + A_BIAS);
    const LAS float* gq = (const LAS float*)(lds + A_GQ);
#pragma unroll
    for (int jj = 0; jj < 2; ++jj) { const int j = htid + 256 * jj;
        if (j < 320) { const int delta = j - 96; float val = -1e30f;
            if (delta >= 0 && delta <= 128) { const int dist = delta * dil; int bucket;
                if (dist < 16) bucket = dist; else { const float d = (float)dist; int lg = 16 + (int)(logf(d / 16.0f) / logf(128.0f) * 16.0f); bucket = lg < 31 ? lg : 31; }
                val = relb[bucket * 12 + head] * 1.4426950408889634f; }
            biasT[j] = val; } }
    const int kr = htid >> 2, qt = htid & 3;
    v4u kreg[4], vreg[4];
#define AT_LOAD(t_) do { const int ks0_ = 128 * (qb - 1) + 64 * (t_); if (ks0_ >= 0) { const size_t ktok_ = rowb + (size_t)(ks0_ + kr) * dil + r; const bf16* kp_ = P + pidx(ktok_, 1536 + head * 128 + qt * 32); \
        _Pragma("unroll") for (int i = 0; i < 4; ++i) { kreg[i] = *(const v4u*)(kp_ + 8 * i); vreg[i] = *(const v4u*)(kp_ + (size_t)6 * TH * 256 + 8 * i); } } } while (0)
    const int tstart = (g == 2) ? 2 : 0;
    AT_LOAD(tstart);
    const int qmin = 128 * qb + 32 * w, qsub = qmin + r32; const size_t qtok = rowb + (size_t)qsub * dil + r;
    bf16x8 qf[8];
    { const bf16* qrow = P + pidx(qtok, head * 128); v4u qraw[8]; float ss = 0.f;
#pragma unroll
        for (int kk = 0; kk < 8; ++kk) { qraw[kk] = *(const v4u*)(qrow + 16 * kk + 8 * hh); const v4u q = qraw[kk];
            ss += lo_f(q.x) * lo_f(q.x) + hi_f(q.x) * hi_f(q.x) + lo_f(q.y) * lo_f(q.y) + hi_f(q.y) * hi_f(q.y) + lo_f(q.z) * lo_f(q.z) + hi_f(q.z) * hi_f(q.z) + lo_f(q.w) * lo_f(q.w) + hi_f(q.w) * hi_f(q.w); }
        ss += __shfl_xor(ss, 32);
        const float rs = rsqrtf(ss * (1.0f / 128.0f) + 1e-6f) * (0.08838834764831845f * 1.4426950408889634f);
#pragma unroll
        for (int kk = 0; kk < 8; ++kk) { const v4u q = qraw[kk]; const f32x4 g0 = *(const LAS f32x4*)(gq + 16 * kk + 8 * hh), g1 = *(const LAS f32x4*)(gq + 16 * kk + 8 * hh + 4);
            qf[kk] = pack8(lo_f(q.x) * rs * g0[0], hi_f(q.x) * rs * g0[1], lo_f(q.y) * rs * g0[2], hi_f(q.y) * rs * g0[3], lo_f(q.z) * rs * g1[0], hi_f(q.z) * rs * g1[1], lo_f(q.w) * rs * g1[2], hi_f(q.w) * rs * g1[3]); }
    }
    f32x16 O[4];
#pragma unroll
    for (int dt = 0; dt < 4; ++dt)
#pragma unroll
        for (int i = 0; i < 16; ++i) O[dt][i] = 0.f;
    float m = -1e30f, l = 0.f;
    for (int t = tstart; t < 4; ++t) {
        const int ks0 = 128 * (qb - 1) + 64 * t; const bool tvalid = ks0 >= 0;
        __syncthreads();
        if (tvalid) {
            float ss = 0.f;
#pragma unroll
            for (int i = 0; i < 4; ++i) { const v4u q = kreg[i];
                ss += lo_f(q.x) * lo_f(q.x) + hi_f(q.x) * hi_f(q.x) + lo_f(q.y) * lo_f(q.y) + hi_f(q.y) * hi_f(q.y) + lo_f(q.z) * lo_f(q.z) + hi_f(q.z) * hi_f(q.z) + lo_f(q.w) * lo_f(q.w) + hi_f(q.w) * hi_f(q.w); }
            ss += __shfl_xor(ss, 1); ss += __shfl_xor(ss, 2);
            const float rs = rsqrtf(ss * (1.0f / 128.0f) + 1e-6f);
#pragma unroll
            for (int i = 0; i < 4; ++i) { const v4u q = kreg[i];
                v4u o; o.x = pk2(lo_f(q.x) * rs, hi_f(q.x) * rs); o.y = pk2(lo_f(q.y) * rs, hi_f(q.y) * rs); o.z = pk2(lo_f(q.z) * rs, hi_f(q.z) * rs); o.w = pk2(lo_f(q.w) * rs, hi_f(q.w) * rs);
                *(LAS v4u*)(Kl + kr * 272 + qt * 64 + 16 * i) = o; *(LAS v4u*)(Vl + kr * 320 + qt * 64 + 16 * i) = vreg[i]; }
        }
        __syncthreads();
        if (t < 3) AT_LOAD(t + 1);
        const bool active = tvalid && (qmin + 31 - ks0 >= 0) && (qmin - (ks0 + 63) <= 128);
        if (active) {
            f32x16 p0, p1;
#pragma unroll
            for (int i = 0; i < 16; ++i) { p0[i] = 0.f; p1[i] = 0.f; }
#pragma unroll
            for (int kk = 0; kk < 8; ++kk) { const bf16x8 a0 = *(const LAS bf16x8*)(Kl + r32 * 272 + 32 * kk + 16 * hh), a1 = *(const LAS bf16x8*)(Kl + (32 + r32) * 272 + 32 * kk + 16 * hh);
                p0 = MFMA32(a0, qf[kk], p0); p1 = MFMA32(a1, qf[kk], p1); }
            float mx = -1e30f;
            {
                const LAS float* bp = biasT + (qsub - ks0 + 96 - 4 * hh - 63);
#pragma unroll
                for (int i = 0; i < 16; ++i) { const int ko = (i & 3) + 8 * (i >> 2);
                    p0[i] += bp[63 - ko]; p1[i] += bp[63 - 32 - ko]; mx = fmaxf(mx, fmaxf(p0[i], p1[i])); }
            }
            mx = fmaxf(mx, __shfl_xor(mx, 32));
            const float mnew = fmaxf(m, mx), alpha = __builtin_amdgcn_exp2f(m - mnew); m = mnew;
            float ls = 0.f;
#pragma unroll
            for (int i = 0; i < 16; ++i) { p0[i] = __builtin_amdgcn_exp2f(p0[i] - mnew); p1[i] = __builtin_amdgcn_exp2f(p1[i] - mnew); ls += p0[i] + p1[i]; }
            l = l * alpha + ls;
            if (__ballot(alpha != 1.0f) != 0ull) {
#pragma unroll
            for (int dt = 0; dt < 4; ++dt)
#pragma unroll
                for (int i = 0; i < 16; ++i) O[dt][i] *= alpha;
            }
#pragma unroll
            for (int k4 = 0; k4 < 4; ++k4) {
                bf16x8 pf;
                if (k4 == 0) pf = pack8(p0[0], p0[1], p0[2], p0[3], p0[4], p0[5], p0[6], p0[7]);
                else if (k4 == 1) pf = pack8(p0[8], p0[9], p0[10], p0[11], p0[12], p0[13], p0[14], p0[15]);
                else if (k4 == 2) pf = pack8(p1[0], p1[1], p1[2], p1[3], p1[4], p1[5], p1[6], p1[7]);
                else pf = pack8(p1[8], p1[9], p1[10], p1[11], p1[12], p1[13], p1[14], p1[15]);
#pragma unroll
                for (int dt = 0; dt < 4; ++dt) { LAS unsigned char* p = Vl + (16 * k4 + 4 * hh + q4) * 320 + 2 * (32 * dt + 16 * gg + 4 * p4); const bf16x8 va = tr8(p, p + 8 * 320); O[dt] = MFMA32(va, pf, O[dt]); }
            }
        }
    }
#undef AT_LOAD
    l += __shfl_xor(l, 32);
    const float inv = 1.0f / l;
    bf16* orow = OG + (size_t)g * ((size_t)TH * 512) + qtok * 512 + hs * 128;
#pragma unroll
    for (int dt = 0; dt < 4; ++dt)
#pragma unroll
        for (int rq = 0; rq < 4; ++rq) { v2u wv; wv.x = pk2(O[dt][4 * rq] * inv, O[dt][4 * rq + 1] * inv); wv.y = pk2(O[dt][4 * rq + 2] * inv, O[dt][4 * rq + 3] * inv);
            *(v2u*)(orow + 32 * dt + 8 * rq + 4 * hh) = wv; }
    if (hh == 0) LSE[qtok * 12 + head] = m * 0.6931471805599453f + __logf(l);
}

#define XB_TMO      128
#define XB_XCNT(j)  (256  + 64 * (j))
#define XB_XSUB(j)  (1280 + 64 * (j))
#define XB_XGEN(j)  (2304 + 64 * (j))
#define XB_TOP      3328
#define XB_TOPGEN   3392
#define XCD_BAR_WORDS 3456
#define XB_SPIN_CAP (1u << 18)

__device__ __forceinline__ unsigned xb_ld(unsigned* p)              { return __hip_atomic_load(p, __ATOMIC_RELAXED, __HIP_MEMORY_SCOPE_AGENT); }
__device__ __forceinline__ unsigned xb_add(unsigned* p, unsigned v) { return __hip_atomic_fetch_add(p, v, __ATOMIC_RELAXED, __HIP_MEMORY_SCOPE_AGENT); }
__device__ __forceinline__ unsigned xb_xcc_id() { return (unsigned)__builtin_amdgcn_s_getreg((3 << 11) | 20) & 0xFu; }
#define XB_SPIN(cond, bar) do { unsigned _sp = 0; while (cond) { __builtin_amdgcn_s_sleep(1); \
    if ((++_sp & 255u) == 0u) { if (xb_ld(&(bar)[XB_TMO])) break; if (_sp > XB_SPIN_CAP) { atomicAdd(&(bar)[XB_TMO], 1u); break; } } } } while (0)

struct XcdBarrier {
    unsigned* bar; unsigned x;
    volatile LAS unsigned* st;
};

__device__ __forceinline__ XcdBarrier xcd_barrier_post(unsigned* bar, volatile LAS unsigned* st) {
    XcdBarrier b; b.bar = bar; b.x = xb_xcc_id(); b.st = st;
    if (threadIdx.x == 0) (void)xb_add(&bar[XB_XCNT(b.x)], 1u);
    return b;
}
__device__ __forceinline__ void xcd_barrier_complete(unsigned* bar, unsigned x, unsigned& nloc, unsigned& nx) {
    const unsigned G = gridDim.x * gridDim.y * gridDim.z;
    unsigned sum, cnt, mine, sp = 0u;
    for (;;) {
        sum = 0u; cnt = 0u; mine = 0u;
#pragma unroll
        for (unsigned j = 0; j < 16; ++j) { const unsigned c = xb_ld(&bar[XB_XCNT(j)]); sum += c; cnt += (c > 0u) ? 1u : 0u; mine = (j == x) ? c : mine; }
        if (sum == G) break;
        __builtin_amdgcn_s_sleep(1);
        if ((++sp & 255u) == 0u) { if (xb_ld(&bar[XB_TMO])) break; if (sp > XB_SPIN_CAP) { atomicAdd(&bar[XB_TMO], 1u); break; } }
    }
    nloc = mine > 0u ? mine : 1u; nx = cnt > 0u ? cnt : 1u;
}

__device__ __forceinline__ void xcd_barrier(const XcdBarrier& b) {
    asm volatile("s_waitcnt vmcnt(0)" ::: "memory");
    __syncthreads();
    if (threadIdx.x == 0) {
        unsigned* bar = b.bar;
        __builtin_amdgcn_s_waitcnt(0);
        unsigned nloc = b.st[0], nx = b.st[1];
        if (nloc == 0u) { xcd_barrier_complete(bar, b.x, nloc, nx); b.st[0] = nloc; b.st[1] = nx; }
        const unsigned old = xb_add(&bar[XB_XSUB(b.x)], 1u);
        const unsigned gen = old / nloc;
        if (old + 1u == (gen + 1u) * nloc) {
            __builtin_amdgcn_fence(__ATOMIC_RELEASE, "agent");
            asm volatile("s_waitcnt vmcnt(0)" ::: "memory");
            const unsigned og = xb_add(&bar[XB_TOP], 1u);
            const unsigned tg = og / nx;
            if (og + 1u == (tg + 1u) * nx) xb_add(&bar[XB_TOPGEN], 1u);
            else XB_SPIN(xb_ld(&bar[XB_TOPGEN]) == tg, bar);
            __builtin_amdgcn_fence(__ATOMIC_ACQUIRE, "agent");
            xb_add(&bar[XB_XGEN(b.x)], 1u);
            asm volatile("s_waitcnt vmcnt(0)" ::: "memory");
        } else {
            XB_SPIN(xb_ld(&bar[XB_XGEN(b.x)]) == gen, bar);
            __builtin_amdgcn_fence(__ATOMIC_ACQUIRE, "agent");
            asm volatile("s_waitcnt vmcnt(0)" ::: "memory");
        }
    }
    __syncthreads();
}

#ifndef REP_G1
#define REP_G1 1
#endif
#ifndef REP_ML
#define REP_ML 1
#endif
#ifndef REP_ATT
#define REP_ATT 1
#endif
#ifndef REP_MIX
#define REP_MIX 1
#endif
#ifndef REP_FFN
#define REP_FFN 1
#endif
struct Args { const float* in[19]; float* out; unsigned char* ws; };

__global__ void __launch_bounds__(512, 2) fwd_mega(Args a) {
    extern __shared__ __attribute__((aligned(16))) unsigned char lds_raw[];
    LAS unsigned char* lds = (LAS unsigned char*)lds_raw;
    cg::grid_group grid = cg::this_grid();
#define FRESH_IDS() int tid = threadIdx.x; asm volatile("" : "+v"(tid)); const int lane = tid & 63, wave = __builtin_amdgcn_readfirstlane(tid >> 6), gw = bx * 8 + wave; (void)lane; (void)gw
    const int G = gridDim.x, bx = blockIdx.x, ngw = G * 8;
    unsigned char* ws = a.ws;
    float* ada = (float*)(ws + WS_ADA); unsigned* ctl = (unsigned*)(ws + WS_CTL); float* rowss = (float*)(ws + WS_ROWSS); float* bias2 = (float*)(ws + WS_BIAS2);
    bf16* WinT = (bf16*)(ws + WS_WIN); bf16* WattT = (bf16*)(ws + WS_WATT); bf16* WmlT = (bf16*)(ws + WS_WML); bf16* WoutT = (bf16*)(ws + WS_WOUT); bf16* Wff1T = (bf16*)(ws + WS_WFF1); bf16* Wff2T = (bf16*)(ws + WS_WFF2);
    float* IFg = (float*)(ws + WS_IF); bf16* U = (bf16*)(ws + WS_U); bf16* P = (bf16*)(ws + WS_P); bf16* HID = (bf16*)(ws + WS_HID); bf16* OG = (bf16*)(ws + WS_OG); bf16* YPRE = (bf16*)(ws + WS_YPRE);
    float* LSE = (float*)(ws + WS_LSE); bf16* Hb = (bf16*)(ws + WS_H); bf16* ATT = (bf16*)(ws + WS_ATT);
    const float* x = a.in[0]; float* out = a.out;
    volatile LAS unsigned* bst = (volatile LAS unsigned*)(lds + LDS_BYTES - 16);
    if (threadIdx.x == 0) { bst[0] = 0u; bst[1] = 0u; }
    __syncthreads();
    (void)xcd_barrier_post(ctl + 4096, bst);
#define GBAR() do { XcdBarrier xb_; xb_.bar = (unsigned*)(a.ws + WS_CTL) + 4096; xb_.x = xb_xcc_id(); xb_.st = (volatile LAS unsigned*)(lds + LDS_BYTES - 16); xcd_barrier(xb_); } while (0)

    {
        FRESH_IDS();
        LAS float* scr = (LAS float*)(lds + wave * 16384);
        constexpr int I0 = 3840, I1 = 1024, I2 = 16, I3 = 256, I4 = 512, I5 = 512, I6 = 2048, I7 = 2048, I8 = 768;
        constexpr int NIT = I0 + I1 + I2 + I3 + I4 + I5 + I6 + I7 + I8;
        for (int it = gw; it < NIT; it += ngw) {
            int r = it;
            if (r < I8) { ada_item(a.in[1], a.in[2], a.in[3], ada, scr, r, lane); continue; } r -= I8;
            if (r < I0) { wseg(a.in[6], DIN, 1024, 240, 0, 0, WinT, scr, r, lane); continue; } r -= I0;
            if (r < I1) { wseg(a.in[6], DIN, 1024, 64, 7696, 7680, WinT, scr, r, lane); continue; } r -= I1;
            if (r < I2) { wseg(a.in[6], DIN, 1024, 1, 7680, 9728, WinT, scr, r, lane); continue; } r -= I2;
            if (r < I3) { wseg(a.in[14], 1024, 512, 32, 0, 0, WattT, scr, r, lane); continue; } r -= I3;
            if (r < I4) { wseg(a.in[15], 1024, 1024, 32, 0, 0, WmlT, scr, r, lane); continue; } r -= I4;
            if (r < I5) { wseg(a.in[16], 1024, 1024, 32, 0, 0, WoutT, scr, r, lane); continue; } r -= I5;
            if (r < I6) { wseg(a.in[17], 4096, 1024, 128, 0, 0, Wff1T, scr, r, lane); continue; } r -= I6;
            wseg(a.in[18], 1024, 4096, 32, 0, 0, Wff2T, scr, r, lane);
        }
    }
    grid.sync();
    { FRESH_IDS(); LAS float* scr = (LAS float*)(lds + wave * 16384);
      for (int it = gw; it < 512; it += ngw) bias2_item(ada, a.in[17], bias2, scr, it, lane);
      prenorm_rows(x, a.in[4], ada, 0, 1024, U, 0, T_ALL, gw, ngw, lane); }
    GBAR();

    for (int hb = 0; hb < 2; ++hb) {
        const int grow0 = hb * TH;
        for (int rep = 0; rep < REP_G1; ++rep) {
        { pg8::Gemm g{U + (size_t)grow0 * 1024, WinT, TH, 38 * 256, 1024}; pg8::StaticOrder S; S.init(TH, 38 * 256, G, bx);
          EpiInProjMain E{P, IFg + (size_t)grow0 * 16, a.in[7]};
          pg8::gemm_phase<EpiInProjMain, pg8::StaticOrder, true, true>(lds, g, S, E); }
        __syncthreads();
        { FRESH_IDS();
          if ((gw & 1) == 0 && (gw >> 1) < TH / 32) if_rows(U + (size_t)grow0 * 1024, WinT + (size_t)9728 * 1024, IFg + (size_t)grow0 * 16, a.in[7], gw >> 1, lane); }
        }
        GBAR();
        for (int rep = 0; rep < REP_MIX; ++rep)
        {
            FRESH_IDS();
            for (int r2 = 0; r2 < REP_ML; ++r2) for (int seq = bx; seq < 128; seq += G) mlstm_seq(lds, P, IFg + (size_t)grow0 * 16, Hb, a.in[8], a.in[9], a.in[13], seq);
            if (tid < 128) ((LAS float*)(lds + A_GQ))[tid] = a.in[10][tid] * a.in[11][tid];
            LAS int* s_unit = (LAS int*)(lds + A_UNIT);
            for (int r3 = 0; r3 < REP_ATT; ++r3) {
                unsigned* ctr = ctl + 64 * hb + 128 * rep + 256 * r3;
                __syncthreads();
                if (tid == 0) s_unit[0] = (int)atomicAdd(ctr, 1u);
                __syncthreads();
                int u = s_unit[0], par = 0;
                while (u < 1536) {
                    int nxt = 0;
                    if (tid == 0) nxt = (int)atomicAdd(ctr, 1u);
                    attn_unit(lds, P, OG, LSE, a.in[12], u);
                    if (tid == 0) s_unit[par ^ 1] = nxt;
                    __syncthreads();
                    par ^= 1; u = s_unit[par];
                }
            }
        }
        GBAR();
        { FRESH_IDS();
        for (int i = bx * 512 + tid; i < TH * 64; i += G * 512) {
            const int tok = i >> 6, rem = i & 63, hs = rem >> 4, ch = rem & 15;
            const float l0 = LSE[tok * 12 + hs], l1 = LSE[tok * 12 + 4 + hs], l2 = LSE[tok * 12 + 8 + hs];
            const float mx = fmaxf(l0, fmaxf(l1, l2)); float w0 = __expf(l0 - mx), w1 = __expf(l1 - mx), w2 = __expf(l2 - mx); const float inv = 1.0f / (w0 + w1 + w2); w0 *= inv; w1 *= inv; w2 *= inv;
            const size_t off = (size_t)tok * 512 + hs * 128 + ch * 8;
            const v4u o0 = *(const v4u*)(OG + off), o1 = *(const v4u*)(OG + (size_t)TH * 512 + off), o2 = *(const v4u*)(OG + (size_t)2 * TH * 512 + off);
            v4u r;
            r.x = pk2(w0 * lo_f(o0.x) + w1 * lo_f(o1.x) + w2 * lo_f(o2.x), w0 * hi_f(o0.x) + w1 * hi_f(o1.x) + w2 * hi_f(o2.x));
            r.y = pk2(w0 * lo_f(o0.y) + w1 * lo_f(o1.y) + w2 * lo_f(o2.y), w0 * hi_f(o0.y) + w1 * hi_f(o1.y) + w2 * hi_f(o2.y));
            r.z = pk2(w0 * lo_f(o0.z) + w1 * lo_f(o1.z) + w2 * lo_f(o2.z), w0 * hi_f(o0.z) + w1 * hi_f(o1.z) + w2 * hi_f(o2.z));
            r.w = pk2(w0 * lo_f(o0.w) + w1 * lo_f(o1.w) + w2 * lo_f(o2.w), w0 * hi_f(o0.w) + w1 * hi_f(o1.w) + w2 * hi_f(o2.w));
            *(v4u*)(ATT + off) = r;
        } }
        GBAR();
        { pg8::Gemm g{ATT, WattT, TH, 1024, 512}; pg8::StaticOrder S; S.init(TH, 1024, G, bx);
          EpiY1 E{P, YPRE};
          pg8::gemm_phase<EpiY1, pg8::StaticOrder, true, true>(lds, g, S, E); }
        __syncthreads();
        { pg8::Gemm g{Hb, WmlT, TH, 1024, 1024}; pg8::StaticOrder S; S.init(TH, 1024, G, bx);
          EpiYpre E{P, YPRE};
          pg8::gemm_phase<EpiYpre, pg8::StaticOrder, true, true>(lds, g, S, E); }
        GBAR();
        { pg8::Gemm g{YPRE, WoutT, TH, 1024, 1024}; pg8::StaticOrder S; S.init(TH, 1024, G, bx);
          EpiResidU2 E{x + (size_t)grow0 * 1024, out + (size_t)grow0 * 1024, ada, a.in[5], U + (size_t)grow0 * 1024, rowss + grow0, grow0};
          pg8::gemm_phase<EpiResidU2, pg8::StaticOrder, true, true>(lds, g, S, E); }
        GBAR();
        for (int rep = 0; rep < REP_FFN; ++rep)
        { pg8::Gemm g{U + (size_t)grow0 * 1024, Wff1T, TH, 4096, 1024}; pg8::StaticOrder S; S.init(TH, 4096, G, bx);
          EpiRelu2 E{HID, rowss + grow0, bias2, grow0};
          pg8::gemm_phase<EpiRelu2, pg8::StaticOrder, true, true>(lds, g, S, E); }
        GBAR();
        { pg8::Gemm g{HID, Wff2T, TH, 1024, 4096}; pg8::StaticOrder S; S.init(TH, 1024, G, bx);
          EpiResid E{out + (size_t)grow0 * 1024, out + (size_t)grow0 * 1024, ada + 5120, grow0};
          pg8::gemm_phase<EpiResid, pg8::StaticOrder, true, true>(lds, g, S, E); }
        if (hb == 0) GBAR();
    }
}

extern "C" void kernel_launch(void* const* d_in, const int* in_sizes, int n_in, void* d_out, int out_size, void* d_ws, size_t ws_size, hipStream_t stream) {
    static int grid = 0;
    if (grid == 0) {
        if (n_in != 19 || ws_size < WS_END) { fprintf(stderr, "kernel_launch: unexpected problem (n_in %d, ws %zu)\n", n_in, ws_size); grid = -1; return; }
        int dev = 0, cus = 0, per_cu = 0;
        hipGetDevice(&dev); hipDeviceGetAttribute(&cus, hipDeviceAttributeMultiprocessorCount, dev);
        if (hipFuncSetAttribute((const void*)fwd_mega, hipFuncAttributeMaxDynamicSharedMemorySize, LDS_BYTES) != hipSuccess) { fprintf(stderr, "kernel_launch: hipFuncSetAttribute failed\n"); grid = -1; return; }
        if (hipOccupancyMaxActiveBlocksPerMultiprocessor(&per_cu, (const void*)fwd_mega, 512, LDS_BYTES) != hipSuccess || per_cu < 1) { fprintf(stderr, "kernel_launch: occupancy query gave %d\n", per_cu); per_cu = 1; }
        (void)hipGetLastError();
        grid = cus * per_cu;
    }
    if (grid < 0) return;
    hipMemsetAsync((char*)d_ws + WS_ADA, 0, WS_ZERO_BYTES, stream);
    Args a{};
    for (int i = 0; i < 19; ++i) a.in[i] = (const float*)d_in[i];
    a.out = (float*)d_out; a.ws = (unsigned char*)d_ws;
    void* args[] = {&a};
    hipError_t e = hipLaunchCooperativeKernel((const void*)fwd_mega, dim3(grid), dim3(512), args, LDS_BYTES, stream);
    if (e != hipSuccess) fprintf(stderr, "cooperative launch failed: %s (grid %d)\n", hipGetErrorString(e), grid);
}
```

```cpp
#include <hip/hip_runtime.h>
#include <hip/hip_cooperative_groups.h>
#include <cstdio>
#include <cstdint>
namespace cg = cooperative_groups;
namespace pg8 {
#define PG8_LAS __attribute__((address_space(3)))
typedef unsigned short bf16_t;
typedef short bf16x8 __attribute__((ext_vector_type(8)));
typedef float f32x4 __attribute__((ext_vector_type(4)));
typedef unsigned u32x4 __attribute__((ext_vector_type(4)));
constexpr int BM = 256, BK = 64, HALF = 128, HTB = HALF * BK * 2  , STAGE_BYTES = 8 * HTB, NXCD = 8, WGM = 8;

__host__ __device__ __forceinline__ int lds_byte(int r, int c) { const int st = (r >> 4) * 2 + (c >> 5), rr = r & 15, cc = c & 31, ob = rr * 64 + cc * 2; return st * 1024 + (ob ^ (((ob >> 9) & 1) << 5)); }
__host__ __device__ __forceinline__ void stage_rc(int b, int& R, int& C) { const int st = b / 1024, sb = b % 1024, swz = sb ^ (((sb >> 9) & 1) << 5); R = (st >> 1) * 16 + swz / 64; C = (st & 1) * 32 + (swz % 64) / 2; }
__host__ __device__ __forceinline__ int perm32(int rho) { const int n = rho >> 4, i = rho & 15; return 8 * (i >> 2) + 4 * n + (i & 3); }

struct Unit { int pm, pn; };
struct Gemm { const bf16_t* A; const bf16_t* Bt; int M, N, K; };

struct StaticOrder {
    int nM, nN, nwg, G, c;
    __host__ __device__ void init(int M, int N, int G_, int c_) { nM = M / BM; nN = N / BM; nwg = nM * nN; G = G_; c = c_; }
    __host__ __device__ bool next(int i, Unit& u) const {
        const long L = (long)i * G + c; if (L >= nwg) return false;
        int wgid = (int)L; { const int q = nwg / NXCD, r = nwg % NXCD, xcd = wgid % NXCD, off = wgid / NXCD; wgid = (xcd < r ? xcd * (q + 1) : r * (q + 1) + (xcd - r) * q) + off; }
        const int nig = WGM * nN, gid = wgid / nig, fm = gid * WGM, gsz = (nM - fm) < WGM ? (nM - fm) : WGM;
        u.pm = fm + ((wgid % nig) % gsz); u.pn = (wgid % nig) / gsz; return true;
    }
    __device__ __forceinline__ void a_ready(const Unit&) const {}
    __device__ __forceinline__ void done(const Unit&) const {}
};

__device__ __forceinline__ unsigned cvt_pk_bf16(float lo, float hi) { unsigned r; asm volatile("v_cvt_pk_bf16_f32 %0, %1, %2" : "=v"(r) : "v"(lo), "v"(hi)); return r; }
typedef float f32x2 __attribute__((ext_vector_type(2)));
template <class Epi, class Sched, bool ALIGN_EPI = false, bool SP2 = false>
__device__ __forceinline__ void gemm_phase(PG8_LAS unsigned char* lds, const Gemm g, const Sched& S, const Epi& E) {
    int tid_ = threadIdx.x; asm volatile("" : "+v"(tid_));
    const int tid = tid_, wid = __builtin_amdgcn_readfirstlane(tid >> 6), lane = tid & 63, wr = wid >> 2, wc = wid & 3, fr = lane & 15, fq = lane >> 4;
    const int K = g.K, nt = K / BK;
    unsigned voffA[2], voffB[2];
#pragma unroll
    for (int i = 0; i < 2; ++i) { int R, C; stage_rc(tid * 16 + i * 8192, R, C); const int Rb = Epi::PERM ? ((R & ~31) + perm32(R & 31)) : R;
        voffA[i] = (unsigned)(R * K + C) * 2u; voffB[i] = (unsigned)(Rb * K + C) * 2u; }
    const size_t kstep = (size_t)(BK * 2);
    const size_t hstep = (size_t)HALF * K * 2;
    const size_t tstep = 2 * hstep;
    const unsigned ldsw = (unsigned)wid * 1024u;
    const int aoff = lds_byte(wr * 64 + fr, fq * 8), boff = lds_byte(wc * 32 + fr, fq * 8);
#define PG8_SA(b, h) (((b) * 2 + (h)) * HTB)
#define PG8_SB(b, h) ((4 + (b) * 2 + (h)) * HTB)
#define PG8_STAGE(bufoff, gbase, voff) do { _Pragma("unroll") for (int _i = 0; _i < 2; ++_i) \
        __builtin_amdgcn_global_load_lds((const unsigned*)((const char*)(gbase) + (voff)[_i]), (PG8_LAS unsigned*)(lds + (bufoff) + ldsw + _i * 8192), 16, 0, 0); } while (0)
#define PG8_LDA(dst, b, h) do { _Pragma("unroll") for (int m = 0; m < 4; ++m) _Pragma("unroll") for (int k = 0; k < 2; ++k) dst[m][k] = *(const PG8_LAS bf16x8*)(lds + PG8_SA(b, h) + aoff + m * 2048 + k * 1024); } while (0)
#define PG8_LDB(dst, b, h) do { _Pragma("unroll") for (int n = 0; n < 2; ++n) _Pragma("unroll") for (int k = 0; k < 2; ++k) dst[n][k] = *(const PG8_LAS bf16x8*)(lds + PG8_SB(b, h) + boff + n * 2048 + k * 1024); } while (0)
#define PG8_MMA(ai, bj, At, Bt) do { __builtin_amdgcn_s_setprio(1); _Pragma("unroll") for (int m = 0; m < 4; ++m) _Pragma("unroll") for (int n = 0; n < 2; ++n) _Pragma("unroll") for (int k = 0; k < 2; ++k) \
        acc[ai][bj][m][n] = __builtin_amdgcn_mfma_f32_16x16x32_bf16(Bt[n][k], At[m][k], acc[ai][bj][m][n], 0, 0, 0); __builtin_amdgcn_s_setprio(0); } while (0)
#define PG8_WAIT_V(n) asm volatile("s_waitcnt vmcnt(" #n ")" ::: "memory")
#define PG8_WAIT_L(n) asm volatile("s_waitcnt lgkmcnt(" #n ")" ::: "memory")
#define PG8_BAR __builtin_amdgcn_s_barrier()
#define PG8_SCHED __builtin_amdgcn_sched_barrier(0)
    Unit cur, nxt; int ui = 0;
    if (!S.next(0, cur)) return;
    f32x4 acc[2][2][4][2];
#pragma unroll
    for (int a = 0; a < 2; ++a)
#pragma unroll
        for (int b = 0; b < 2; ++b)
#pragma unroll
            for (int m = 0; m < 4; ++m)
#pragma unroll
                for (int n = 0; n < 2; ++n) acc[a][b][m][n] = (f32x4){0.f, 0.f, 0.f, 0.f};
    bf16x8 At[4][2], B0[2][2], B1[2][2];
    const char* cA = (const char*)g.A + (size_t)cur.pm * tstep; const char* cB = (const char*)g.Bt + (size_t)cur.pn * tstep;
    S.a_ready(cur);
    if constexpr (SP2) {
        PG8_STAGE(PG8_SB(0, 0), cB, voffB); PG8_STAGE(PG8_SB(0, 1), cB + hstep, voffB); PG8_STAGE(PG8_SA(0, 0), cA, voffA); PG8_STAGE(PG8_SA(0, 1), cA + hstep, voffA);
        if (wr == 1) PG8_BAR;
        PG8_WAIT_V(2); PG8_BAR;
        PG8_STAGE(PG8_SB(1, 0), cB + kstep, voffB); PG8_STAGE(PG8_SA(1, 0), cA + kstep, voffA); PG8_STAGE(PG8_SB(1, 1), cB + hstep + kstep, voffB);
        PG8_WAIT_V(6); PG8_BAR;
    } else {
        PG8_STAGE(PG8_SB(0, 0), cB, voffB); PG8_STAGE(PG8_SA(0, 0), cA, voffA); PG8_STAGE(PG8_SB(0, 1), cB + hstep, voffB); PG8_STAGE(PG8_SA(0, 1), cA + hstep, voffA);
        if (wr == 1) PG8_BAR;
        PG8_WAIT_V(4); PG8_BAR;
        PG8_STAGE(PG8_SB(1, 0), cB + kstep, voffB); PG8_STAGE(PG8_SA(1, 0), cA + kstep, voffA); PG8_STAGE(PG8_SB(1, 1), cB + hstep + kstep, voffB);
        PG8_WAIT_V(6); PG8_BAR;
    }
    for (;;) {
        const bool has_next = S.next(ui + 1, nxt);
        const char* nA = has_next ? (const char*)g.A + (size_t)nxt.pm * tstep : cA; const char* nB = has_next ? (const char*)g.Bt + (size_t)nxt.pn * tstep : cB;
        for (int t = 0; t < nt; t += 2) {
            const bool last = (t == nt - 2);
            const char* a1 = cA + (size_t)(t + 1) * kstep;
            const char* a2 = last ? nA : cA + (size_t)(t + 2) * kstep; const char* b2 = last ? nB : cB + (size_t)(t + 2) * kstep;
            const char* a3 = a2 + kstep; const char* b3 = b2 + kstep;
            if (last && has_next) S.a_ready(nxt);
            if constexpr (SP2) {
            PG8_LDB(B0, 0, 0); PG8_LDB(B1, 0, 1); PG8_SCHED; PG8_LDA(At, 0, 0); PG8_STAGE(PG8_SA(1, 1), a1 + hstep, voffA);
            PG8_WAIT_V(8); PG8_WAIT_L(0); PG8_BAR; PG8_MMA(0, 0, At, B0); PG8_MMA(0, 1, At, B1); PG8_BAR; PG8_SCHED;
            PG8_LDA(At, 0, 1); PG8_STAGE(PG8_SB(0, 0), b2, voffB); PG8_STAGE(PG8_SB(0, 1), b2 + hstep, voffB); PG8_STAGE(PG8_SA(0, 0), a2, voffA);
            PG8_WAIT_V(8); PG8_WAIT_L(0); PG8_BAR; PG8_MMA(1, 0, At, B0); PG8_MMA(1, 1, At, B1); PG8_BAR; PG8_SCHED;
            PG8_LDB(B0, 1, 0); PG8_LDB(B1, 1, 1); PG8_SCHED; PG8_LDA(At, 1, 0); PG8_STAGE(PG8_SA(0, 1), a2 + hstep, voffA);
            PG8_WAIT_V(8); PG8_WAIT_L(0); PG8_BAR; PG8_MMA(0, 0, At, B0); PG8_MMA(0, 1, At, B1); PG8_BAR; PG8_SCHED;
            PG8_LDA(At, 1, 1); PG8_STAGE(PG8_SB(1, 0), b3, voffB); PG8_STAGE(PG8_SB(1, 1), b3 + hstep, voffB); PG8_STAGE(PG8_SA(1, 0), a3, voffA);
            PG8_WAIT_V(8); PG8_WAIT_L(0); PG8_BAR; PG8_MMA(1, 0, At, B0); PG8_MMA(1, 1, At, B1); PG8_BAR; PG8_SCHED;
            } else {
            PG8_LDB(B0, 0, 0); PG8_SCHED; PG8_LDA(At, 0, 0); PG8_STAGE(PG8_SA(1, 1), a1 + hstep, voffA);
            PG8_WAIT_L(8); PG8_BAR; PG8_WAIT_L(0); PG8_MMA(0, 0, At, B0); PG8_BAR; PG8_SCHED;
            PG8_LDB(B1, 0, 1); PG8_STAGE(PG8_SB(0, 0), b2, voffB);
            PG8_BAR; PG8_WAIT_L(0); PG8_MMA(0, 1, At, B1); PG8_BAR;
            PG8_LDA(At, 0, 1); PG8_STAGE(PG8_SA(0, 0), a2, voffA);
            PG8_BAR; PG8_WAIT_L(0); PG8_MMA(1, 0, At, B0); PG8_BAR; PG8_SCHED;
            PG8_STAGE(PG8_SB(0, 1), b2 + hstep, voffB);
            PG8_WAIT_V(6); PG8_BAR; PG8_MMA(1, 1, At, B1); PG8_BAR;
            PG8_LDB(B0, 1, 0); PG8_SCHED; PG8_LDA(At, 1, 0); PG8_STAGE(PG8_SA(0, 1), a2 + hstep, voffA);
            PG8_WAIT_L(8); PG8_BAR; PG8_WAIT_L(0); PG8_MMA(0, 0, At, B0); PG8_BAR; PG8_SCHED;
            PG8_LDB(B1, 1, 1); PG8_STAGE(PG8_SB(1, 0), b3, voffB);
            PG8_BAR; PG8_WAIT_L(0); PG8_MMA(0, 1, At, B1); PG8_BAR;
            PG8_LDA(At, 1, 1); PG8_STAGE(PG8_SA(1, 0), a3, voffA);
            PG8_BAR; PG8_WAIT_L(0); PG8_MMA(1, 0, At, B0); PG8_BAR; PG8_SCHED;
            PG8_STAGE(PG8_SB(1, 1), b3 + hstep, voffB);
            PG8_WAIT_V(6); PG8_BAR; PG8_MMA(1, 1, At, B1); PG8_BAR;
            }
        }
        if constexpr (ALIGN_EPI) { if (wr == 0) PG8_BAR; }
        if constexpr (!Epi::AFTER_DRAIN) { E(acc, cur, wr, wc, fr, fq); S.done(cur); }
        if (!has_next) break;
#pragma unroll
        for (int a = 0; a < 2; ++a)
#pragma unroll
            for (int b = 0; b < 2; ++b)
#pragma unroll
                for (int m = 0; m < 4; ++m)
#pragma unroll
                    for (int n = 0; n < 2; ++n) acc[a][b][m][n] = (f32x4){0.f, 0.f, 0.f, 0.f};
        cur = nxt; cA = nA; cB = nB; ++ui;
        if constexpr (ALIGN_EPI) { if (wr == 1) PG8_BAR; }
    }
    PG8_WAIT_V(0);
    if constexpr (!ALIGN_EPI) { if (wr == 0) PG8_BAR; }
    PG8_BAR;
    if constexpr (Epi::AFTER_DRAIN) { E.fused(acc, cur, wr, wc, fr, fq, lds, wid, lane); S.done(cur); }
#undef PG8_SA
#undef PG8_SB
#undef PG8_STAGE
#undef PG8_LDA
#undef PG8_LDB
#undef PG8_MMA
#undef PG8_WAIT_V
#undef PG8_WAIT_L
#undef PG8_BAR
#undef PG8_SCHED
}
}

#define LAS __attribute__((address_space(3)))
#define DI __device__ __forceinline__
typedef unsigned short bf16;
typedef unsigned v4u __attribute__((ext_vector_type(4)));
typedef unsigned v2u __attribute__((ext_vector_type(2)));
typedef float f32x4 __attribute__((ext_vector_type(4)));
typedef float f32x16 __attribute__((ext_vector_type(16)));
typedef short bf16x8 __attribute__((ext_vector_type(8)));
typedef short v4i16_t __attribute__((ext_vector_type(4)));
#define MFMA32(a, b, c) __builtin_amdgcn_mfma_f32_32x32x16_bf16((a), (b), (c), 0, 0, 0)
#define LDS_WAIT() asm volatile("s_waitcnt lgkmcnt(0)" ::: "memory")

constexpr int T_ALL = 65536, DM = 1024, SEQ = 2048, TH = 32768, PP = 9728, NPAD = 9984, DIN = 9744;
constexpr size_t MiB = 1u << 20;
constexpr size_t WS_ADA = 0, WS_CTL = 0xC0000, WS_ROWSS = 0x100000, WS_BIAS2 = 0x140000, WS_ZERO_BYTES = 0x1C0000;
constexpr size_t WS_WIN = 2 * MiB, WS_WATT = 22 * MiB, WS_WML = 23 * MiB, WS_WOUT = 25 * MiB, WS_WFF1 = 27 * MiB, WS_WFF2 = 35 * MiB;
constexpr size_t WS_IF = 44 * MiB, WS_U = 48 * MiB, WS_P = 176 * MiB, WS_HID = 176 * MiB, WS_OG = 784 * MiB, WS_YPRE = 784 * MiB;
constexpr size_t WS_LSE = 880 * MiB, WS_H = 882 * MiB, WS_ATT = 946 * MiB, WS_END = 978 * MiB;
constexpr int LDS_BYTES = 147456;

DI size_t pidx(size_t row, int col) { return (size_t)(col >> 8) * ((size_t)TH * 256) + row * 256 + (size_t)(col & 255); }
DI float lo_f(unsigned u) { return __uint_as_float(u << 16); }
DI float hi_f(unsigned u) { return __uint_as_float(u & 0xffff0000u); }
DI float bf2f(unsigned short b) { return __uint_as_float((unsigned)b << 16); }
DI unsigned pk2(float lo, float hi) { return pg8::cvt_pk_bf16(lo, hi); }
DI int crow(int r, int h) { return (r & 3) + 8 * (r >> 2) + 4 * h; }
DI float sigmoidf_(float v) { return __builtin_amdgcn_rcpf(1.0f + __expf(-v)); }
DI float wave_sum(float v) {
#pragma unroll
    for (int o = 1; o < 64; o <<= 1) v += __shfl_xor(v, o);
    return v;
}
DI bf16x8 tr8(LAS unsigned char* plo, LAS unsigned char* phi) {
    v4i16_t a = __builtin_amdgcn_ds_read_tr16_b64_v4i16((LAS v4i16_t*)plo);
    v4i16_t b = __builtin_amdgcn_ds_read_tr16_b64_v4i16((LAS v4i16_t*)phi);
    return __builtin_shufflevector(a, b, 0, 1, 2, 3, 4, 5, 6, 7);
}
DI bf16x8 pack8(float a0, float a1, float a2, float a3, float a4, float a5, float a6, float a7) {
    v4u p; p.x = pk2(a0, a1); p.y = pk2(a2, a3); p.z = pk2(a4, a5); p.w = pk2(a6, a7);
    return __builtin_bit_cast(bf16x8, p);
}

using pg8::Unit;
struct EpiInProj {
    static constexpr bool PERM = true, AFTER_DRAIN = false;
    bf16* P; float* IFg; const float* b_if;
    DI void operator()(const f32x4 (&acc)[2][2][4][2], const Unit& u, int wr, int wc, int fr, int fq) const {
        const int row0 = u.pm * 256 + wr * 64 + fr;
        if (u.pn < 38) {
            const int col0 = u.pn * 256 + wc * 32 + 8 * fq; const bool sg = u.pn >= 26;
#pragma unroll
            for (int ai = 0; ai < 2; ++ai)
#pragma unroll
                for (int m = 0; m < 4; ++m) { bf16* rowp = P + pidx((size_t)(row0 + ai * 128 + m * 16), col0);
#pragma unroll
                    for (int bj = 0; bj < 2; ++bj) { f32x4 v0 = acc[ai][bj][m][0], v1 = acc[ai][bj][m][1];
                        if (sg) {
#pragma unroll
                            for (int i = 0; i < 4; ++i) { v0[i] = sigmoidf_(v0[i]); v1[i] = sigmoidf_(v1[i]); } }
                        v4u w; w.x = pk2(v0[0], v0[1]); w.y = pk2(v0[2], v0[3]); w.z = pk2(v1[0], v1[1]); w.w = pk2(v1[2], v1[3]);
                        __builtin_nontemporal_store(w, (v4u*)(rowp + bj * 128)); } }
        } else if (wc == 0 && fq < 2) {
            f32x4 b0 = *(const f32x4*)(b_if + 8 * fq), b1 = *(const f32x4*)(b_if + 8 * fq + 4);
#pragma unroll
            for (int ai = 0; ai < 2; ++ai)
#pragma unroll
                for (int m = 0; m < 4; ++m) { f32x4 v0 = acc[ai][0][m][0] + b0, v1 = acc[ai][0][m][1] + b1;
                    if (fq == 1) {
#pragma unroll
                        for (int i = 0; i < 4; ++i) { v0[i] = fminf(v0[i], 0.f) - __logf(1.0f + __expf(-fabsf(v0[i]))); v1[i] = fminf(v1[i], 0.f) - __logf(1.0f + __expf(-fabsf(v1[i]))); } }
                    float* o = IFg + (size_t)(row0 + ai * 128 + m * 16) * 16 + 8 * fq;
                    *(f32x4*)o = v0; *(f32x4*)(o + 4) = v1; }
        }
    }
};
template <int SIG> struct EpiProj {
    static constexpr bool PERM = true, AFTER_DRAIN = false;
    bf16* P; int ptile0;
    DI void operator()(const f32x4 (&acc)[2][2][4][2], const Unit& u, int wr, int wc, int fr, int fq) const {
        const int row0 = u.pm * 256 + wr * 64 + fr;
        bf16* base = P + (size_t)(ptile0 + u.pn) * ((size_t)TH * 256) + (size_t)row0 * 256 + wc * 32 + 8 * fq;
#pragma unroll
        for (int ai = 0; ai < 2; ++ai)
#pragma unroll
            for (int m = 0; m < 4; ++m) { bf16* rowp = base + (ai * 128 + m * 16) * 256;
#pragma unroll
                for (int bj = 0; bj < 2; ++bj) { f32x4 v0 = acc[ai][bj][m][0], v1 = acc[ai][bj][m][1];
                    if (SIG) {
#pragma unroll
                        for (int i = 0; i < 4; ++i) { v0[i] = sigmoidf_(v0[i]); v1[i] = sigmoidf_(v1[i]); } }
                    v4u w; w.x = pk2(v0[0], v0[1]); w.y = pk2(v0[2], v0[3]); w.z = pk2(v1[0], v1[1]); w.w = pk2(v1[2], v1[3]);
                    __builtin_nontemporal_store(w, (v4u*)(rowp + bj * 128)); } }
    }
};
struct EpiIF {
    static constexpr bool PERM = true, AFTER_DRAIN = false;
    float* IFg; const float* b_if;
    DI void operator()(const f32x4 (&acc)[2][2][4][2], const Unit& u, int wr, int wc, int fr, int fq) const {
        const int row0 = u.pm * 256 + wr * 64 + fr;
        if (wc == 0 && fq < 2) {
            f32x4 b0 = *(const f32x4*)(b_if + 8 * fq), b1 = *(const f32x4*)(b_if + 8 * fq + 4);
#pragma unroll
            for (int ai = 0; ai < 2; ++ai)
#pragma unroll
                for (int m = 0; m < 4; ++m) { f32x4 v0 = acc[ai][0][m][0] + b0, v1 = acc[ai][0][m][1] + b1;
                    if (fq == 1) {
#pragma unroll
                        for (int i = 0; i < 4; ++i) { v0[i] = fminf(v0[i], 0.f) - __builtin_amdgcn_logf(1.0f + __expf(-fabsf(v0[i]))) * 0.6931471805599453f; v1[i] = fminf(v1[i], 0.f) - __builtin_amdgcn_logf(1.0f + __expf(-fabsf(v1[i]))) * 0.6931471805599453f; } }
                    float* o = IFg + (size_t)(row0 + ai * 128 + m * 16) * 16 + 8 * fq;
                    *(f32x4*)o = v0; *(f32x4*)(o + 4) = v1; }
        }
    }
};
struct EpiY1 {
    static constexpr bool PERM = true, AFTER_DRAIN = false;
    const bf16* P; bf16* Y;
    DI void operator()(const f32x4 (&acc)[2][2][4][2], const Unit& u, int wr, int wc, int fr, int fq) const {
        const int row0 = u.pm * 256 + wr * 64 + fr, col0 = u.pn * 256 + wc * 32 + 8 * fq;
#pragma unroll
        for (int ai = 0; ai < 2; ++ai)
#pragma unroll
            for (int m = 0; m < 4; ++m) { const size_t r = (size_t)(row0 + ai * 128 + m * 16);
#pragma unroll
                for (int bj = 0; bj < 2; ++bj) { const int c = col0 + bj * 128; const v4u g = *(const v4u*)(P + pidx(r, 7680 + c));
                    const f32x4 v0 = acc[ai][bj][m][0], v1 = acc[ai][bj][m][1];
                    v4u w; w.x = pk2(v0[0] * lo_f(g.x), v0[1] * hi_f(g.x)); w.y = pk2(v0[2] * lo_f(g.y), v0[3] * hi_f(g.y)); w.z = pk2(v1[0] * lo_f(g.z), v1[1] * hi_f(g.z)); w.w = pk2(v1[2] * lo_f(g.w), v1[3] * hi_f(g.w));
                    *(v4u*)(Y + r * 1024 + c) = w; } }
    }
};
struct EpiYpre {
    static constexpr bool PERM = true, AFTER_DRAIN = false;
    const bf16* P; bf16* Y;
    DI void operator()(const f32x4 (&acc)[2][2][4][2], const Unit& u, int wr, int wc, int fr, int fq) const {
        const int row0 = u.pm * 256 + wr * 64 + fr, col0 = u.pn * 256 + wc * 32 + 8 * fq;
#pragma unroll
        for (int ai = 0; ai < 2; ++ai)
#pragma unroll
            for (int m = 0; m < 4; ++m) { const size_t r = (size_t)(row0 + ai * 128 + m * 16);
#pragma unroll
                for (int bj = 0; bj < 2; ++bj) { const int c = col0 + bj * 128; const v4u g = *(const v4u*)(P + pidx(r, 8704 + c)); const v4u y = *(const v4u*)(Y + r * 1024 + c);
                    const f32x4 a0 = acc[ai][bj][m][0], a1 = acc[ai][bj][m][1];
                    v4u w; w.x = pk2(lo_f(y.x) + a0[0] * lo_f(g.x), hi_f(y.x) + a0[1] * hi_f(g.x)); w.y = pk2(lo_f(y.y) + a0[2] * lo_f(g.y), hi_f(y.y) + a0[3] * hi_f(g.y));
                    w.z = pk2(lo_f(y.z) + a1[0] * lo_f(g.z), hi_f(y.z) + a1[1] * hi_f(g.z)); w.w = pk2(lo_f(y.w) + a1[2] * lo_f(g.w), hi_f(y.w) + a1[3] * hi_f(g.w));
                    *(v4u*)(Y + r * 1024 + c) = w; } }
    }
};
struct EpiResid {
    static constexpr bool PERM = true, AFTER_DRAIN = false;
    const float* base; float* out; const float* gate; int grow0;
    DI void operator()(const f32x4 (&acc)[2][2][4][2], const Unit& u, int wr, int wc, int fr, int fq) const {
        const int row0 = u.pm * 256 + wr * 64 + fr, col0 = u.pn * 256 + wc * 32 + 8 * fq;
        const int b = (grow0 + u.pm * 256) >> 11;
        f32x4 g[2][2];
#pragma unroll
        for (int bj = 0; bj < 2; ++bj) { const float* gp = gate + (size_t)b * 6144 + col0 + bj * 128; g[bj][0] = *(const f32x4*)gp; g[bj][1] = *(const f32x4*)(gp + 4); }
#pragma unroll
        for (int ai = 0; ai < 2; ++ai)
#pragma unroll
            for (int m = 0; m < 4; ++m) { const size_t r = (size_t)(row0 + ai * 128 + m * 16);
#pragma unroll
                for (int bj = 0; bj < 2; ++bj) { const size_t off = r * 1024 + col0 + bj * 128;
                    f32x4 v0 = *(const f32x4*)(base + off), v1 = *(const f32x4*)(base + off + 4);
                    v0 += g[bj][0] * acc[ai][bj][m][0]; v1 += g[bj][1] * acc[ai][bj][m][1];
                    *(f32x4*)(out + off) = v0; *(f32x4*)(out + off + 4) = v1; } }
    }
};
struct EpiResidU2 {
    static constexpr bool PERM = true, AFTER_DRAIN = false;
    const float* base; float* out; const float* ada; const float* g2; bf16* U2; float* rowss; int grow0;
    DI void operator()(const f32x4 (&acc)[2][2][4][2], const Unit& u, int wr, int wc, int fr, int fq) const {
        const int row0 = u.pm * 256 + wr * 64 + fr, col0 = u.pn * 256 + wc * 32 + 8 * fq;
        const int b = (grow0 + u.pm * 256) >> 11;
        f32x4 g[2][2], gm[2][2];
#pragma unroll
        for (int bj = 0; bj < 2; ++bj) { const int c = col0 + bj * 128; const float* gp = ada + (size_t)b * 6144 + 2048 + c; const float* sp = ada + (size_t)b * 6144 + 4096 + c;
            g[bj][0] = *(const f32x4*)gp; g[bj][1] = *(const f32x4*)(gp + 4);
            gm[bj][0] = *(const f32x4*)(g2 + c) * (*(const f32x4*)sp + 1.0f); gm[bj][1] = *(const f32x4*)(g2 + c + 4) * (*(const f32x4*)(sp + 4) + 1.0f); }
#pragma unroll
        for (int ai = 0; ai < 2; ++ai)
#pragma unroll
            for (int m = 0; m < 4; ++m) { const size_t r = (size_t)(row0 + ai * 128 + m * 16); float ss = 0.f;
#pragma unroll
                for (int bj = 0; bj < 2; ++bj) { const size_t off = r * 1024 + col0 + bj * 128;
                    f32x4 v0 = *(const f32x4*)(base + off), v1 = *(const f32x4*)(base + off + 4);
                    v0 += g[bj][0] * acc[ai][bj][m][0]; v1 += g[bj][1] * acc[ai][bj][m][1];
                    *(f32x4*)(out + off) = v0; *(f32x4*)(out + off + 4) = v1;
                    ss += (v0[0] * v0[0] + v0[1] * v0[1]) + (v0[2] * v0[2] + v0[3] * v0[3]) + (v1[0] * v1[0] + v1[1] * v1[1]) + (v1[2] * v1[2] + v1[3] * v1[3]);
                    const f32x4 u0 = v0 * gm[bj][0], u1 = v1 * gm[bj][1];
                    v4u w; w.x = pk2(u0[0], u0[1]); w.y = pk2(u0[2], u0[3]); w.z = pk2(u1[0], u1[1]); w.w = pk2(u1[2], u1[3]);
                    *(v4u*)(U2 + off) = w; }
                ss += __shfl_xor(ss, 16); ss += __shfl_xor(ss, 32);
                if (fq == 0) atomicAdd(rowss + r, ss); }
    }
};
struct EpiRelu2 {
    static constexpr bool PERM = true, AFTER_DRAIN = false;
    bf16* O; const float* rowss; const float* bias2; int grow0;
    DI void operator()(const f32x4 (&acc)[2][2][4][2], const Unit& u, int wr, int wc, int fr, int fq) const {
        const int row0 = u.pm * 256 + wr * 64 + fr, col0 = u.pn * 256 + wc * 32 + 8 * fq;
        const int bb = (grow0 + u.pm * 256) >> 11;
        f32x4 bs[2][2];
#pragma unroll
        for (int bj = 0; bj < 2; ++bj) { const float* bp = bias2 + (size_t)bb * 4096 + col0 + bj * 128; bs[bj][0] = *(const f32x4*)bp; bs[bj][1] = *(const f32x4*)(bp + 4); }
#pragma unroll
        for (int ai = 0; ai < 2; ++ai)
#pragma unroll
            for (int m = 0; m < 4; ++m) { bf16* rowp = O + (size_t)(row0 + ai * 128 + m * 16) * 4096 + col0;
                const float rstd = rsqrtf(rowss[row0 + ai * 128 + m * 16] * (1.0f / 1024.0f) + 1e-6f);
#pragma unroll
                for (int bj = 0; bj < 2; ++bj) { f32x4 v0 = acc[ai][bj][m][0] * rstd + bs[bj][0], v1 = acc[ai][bj][m][1] * rstd + bs[bj][1];
#pragma unroll
                    for (int i = 0; i < 4; ++i) { float a = fmaxf(v0[i], 0.f), b = fmaxf(v1[i], 0.f); v0[i] = a * a; v1[i] = b * b; }
                    v4u w; w.x = pk2(v0[0], v0[1]); w.y = pk2(v0[2], v0[3]); w.z = pk2(v1[0], v1[1]); w.w = pk2(v1[2], v1[3]);
                    *(v4u*)(rowp + bj * 128) = w; } }
    }
};

DI void transpose_item(const float* W, int ldw, int n0src, bf16* WT, int K, int row0dst, LAS float* scr, int kb, int lane) {
    const int k0 = 64 * kb;
#pragma unroll 8
    for (int i = 0; i < 32; ++i) { const int kk = 2 * i + (lane >> 5); scr[kk * 33 + (lane & 31)] = W[(size_t)(k0 + kk) * ldw + n0src + (lane & 31)]; }
    LDS_WAIT(); asm volatile("" ::: "memory");
    const int c = lane & 7;
#pragma unroll
    for (int j = 0; j < 4; ++j) { const int n = (lane >> 3) + 8 * j; const LAS float* s = scr + (8 * c) * 33 + n;
        v4u o; o.x = pk2(s[0 * 33], s[1 * 33]); o.y = pk2(s[2 * 33], s[3 * 33]); o.z = pk2(s[4 * 33], s[5 * 33]); o.w = pk2(s[6 * 33], s[7 * 33]);
        *(v4u*)(WT + (size_t)(row0dst + n) * K + k0 + 8 * c) = o; }
    LDS_WAIT(); asm volatile("" ::: "memory");
}
DI void wseg(const float* W, int ldw, int K, int ncb, int src0, int dst0, bf16* WT, LAS float* scr, int item, int lane) {
    const int kb = item / ncb, nb = item % ncb;
    transpose_item(W, ldw, src0 + 32 * nb, WT, K, dst0 + 32 * nb, scr, kb, lane);
}
DI void ada_item(const float* c, const float* wada, const float* bada, float* ada, LAS float* scr, int item, int lane) {
    const int cb = item % 96, kc = item / 96;
#pragma unroll 4
    for (int i = 0; i < 64; ++i) { const int idx = i * 64 + lane, k = idx >> 5, b = idx & 31; const float v = c[b * 1024 + kc * 128 + k]; scr[idx] = v * sigmoidf_(v); }
    LDS_WAIT(); asm volatile("" ::: "memory");
    float acc[32];
#pragma unroll
    for (int b = 0; b < 32; ++b) acc[b] = 0.f;
    const float* wp = wada + (size_t)(kc * 128) * 6144 + cb * 64 + lane;
#pragma unroll 2
    for (int k = 0; k < 128; ++k) { const float w = wp[(size_t)k * 6144];
#pragma unroll
        for (int b4 = 0; b4 < 8; ++b4) { const f32x4 sv = *(const LAS f32x4*)(scr + k * 32 + b4 * 4);
            acc[4 * b4] += sv[0] * w; acc[4 * b4 + 1] += sv[1] * w; acc[4 * b4 + 2] += sv[2] * w; acc[4 * b4 + 3] += sv[3] * w; } }
    const int col = cb * 64 + lane; const float bias = (kc == 0) ? bada[col] : 0.f;
#pragma unroll
    for (int b = 0; b < 32; ++b) atomicAdd(ada + b * 6144 + col, acc[b] + bias);
    LDS_WAIT(); asm volatile("" ::: "memory");
}
DI void bias2_item(const float* ada, const float* w1, float* bias2, LAS float* scr, int item, int lane) {
    const int cb = item % 64, kc = item / 64;
#pragma unroll 4
    for (int i = 0; i < 64; ++i) { const int idx = i * 64 + lane, k = idx >> 5, b = idx & 31; scr[idx] = ada[(size_t)b * 6144 + 3072 + kc * 128 + k]; }
    LDS_WAIT(); asm volatile("" ::: "memory");
    float acc[32];
#pragma unroll
    for (int b = 0; b < 32; ++b) acc[b] = 0.f;
    const float* wp = w1 + (size_t)(kc * 128) * 4096 + cb * 64 + lane;
#pragma unroll 2
    for (int k = 0; k < 128; ++k) { const float w = wp[(size_t)k * 4096];
#pragma unroll
        for (int b4 = 0; b4 < 8; ++b4) { const f32x4 sv = *(const LAS f32x4*)(scr + k * 32 + b4 * 4);
            acc[4 * b4] += sv[0] * w; acc[4 * b4 + 1] += sv[1] * w; acc[4 * b4 + 2] += sv[2] * w; acc[4 * b4 + 3] += sv[3] * w; } }
    const int col = cb * 64 + lane;
#pragma unroll
    for (int b = 0; b < 32; ++b) atomicAdd(bias2 + b * 4096 + col, acc[b]);
    LDS_WAIT(); asm volatile("" ::: "memory");
}
DI void prenorm_rows(const float* X, const float* gvec, const float* ada, int sh_off, int sc_off, bf16* U, int row_lo, int row_hi, int gw, int ngw, int lane) {
    const int nrows = row_hi - row_lo, rpw = (nrows + ngw - 1) / ngw; const int m0 = row_lo + gw * rpw; int m1 = m0 + rpw; if (m1 > row_hi) m1 = row_hi;
    int curb = -1; f32x4 mul[4], add[4], nx[4];
    if (m0 < m1) {
#pragma unroll
        for (int j = 0; j < 4; ++j) nx[j] = *(const f32x4*)(X + (size_t)m0 * 1024 + 4 * lane + 256 * j);
    }
    for (int m = m0; m < m1; ++m) {
        const int b = m >> 11;
        f32x4 v[4]; float ss = 0.f;
#pragma unroll
        for (int j = 0; j < 4; ++j) v[j] = nx[j];
        if (m + 1 < m1) {
#pragma unroll
            for (int j = 0; j < 4; ++j) nx[j] = *(const f32x4*)(X + (size_t)(m + 1) * 1024 + 4 * lane + 256 * j);
        }
        if (b != curb) { curb = b;
#pragma unroll
            for (int j = 0; j < 4; ++j) { const int col = 4 * lane + 256 * j; const f32x4 g = *(const f32x4*)(gvec + col), sc = *(const f32x4*)(ada + (size_t)b * 6144 + sc_off + col);
                mul[j] = g * (sc + 1.0f); add[j] = *(const f32x4*)(ada + (size_t)b * 6144 + sh_off + col); } }
#pragma unroll
        for (int j = 0; j < 4; ++j) ss += (v[j][0] * v[j][0] + v[j][1] * v[j][1]) + (v[j][2] * v[j][2] + v[j][3] * v[j][3]);
        const float rstd = rsqrtf(wave_sum(ss) * (1.0f / 1024.0f) + 1e-6f);
#pragma unroll
        for (int j = 0; j < 4; ++j) { const f32x4 o = (v[j] * rstd) * mul[j] + add[j]; v2u w; w.x = pk2(o[0], o[1]); w.y = pk2(o[2], o[3]);
            *(v2u*)(U + (size_t)m * 1024 + 4 * lane + 256 * j) = w; }
    }
}
constexpr int M_Q = 0, M_K = 9216, M_K2 = 18432, M_V = 30720, M_C = 51200, M_GATE = 71680, M_NPART = 73216, M_SSQ = 75264, M_NVEC = 76288, M_CW = 76544, M_MLG = 79104, M_SLOT = 79616;
DI void mlstm_seq(LAS unsigned char* lds, const bf16* P, const float* IFg, bf16* Hout, const float* conv_w, const float* conv_b, const float* mlg, int seq) {
    int tid_ = threadIdx.x; asm volatile("" : "+v"(tid_));
    const int tid = tid_, wv = __builtin_amdgcn_readfirstlane(tid >> 6), lane = tid & 63, r32 = lane & 31, hh = lane >> 5;
    const int dvs = wv & 3, th = wv >> 2, i16 = lane & 15, q4 = i16 >> 2, p4 = i16 & 3, gg = (lane >> 4) & 1;
    const int bl = seq >> 3, hd = seq & 7; const size_t rowb = (size_t)bl * 2048;
    LAS unsigned char* Qt = lds + M_Q; LAS unsigned char* Kt = lds + M_K; LAS unsigned char* Kt2 = lds + M_K2; LAS unsigned char* Vt = lds + M_V; LAS unsigned char* Cimg = lds + M_C;
    LAS float* gate = (LAS float*)(lds + M_GATE); LAS float* npart = (LAS float*)(lds + M_NPART); LAS float* ssq = (LAS float*)(lds + M_SSQ); LAS float* nvec = (LAS float*)(lds + M_NVEC);
    const int isk = (tid >> 8) & 1, cgp = (tid >> 5) & 7, rg = tid & 31;
    const int chb = isk * 512 + hd * 64 + 8 * cgp, lch = isk * 64 + 8 * cgp;
    f32x16 Cst;
#pragma unroll
    for (int i = 0; i < 16; ++i) Cst[i] = 0.f;
    float n_reg = 0.f, m_run = 0.f;
    for (int i = tid; i < 1280; i += 512) *(LAS v4u*)(Cimg + 16 * i) = (v4u){0u, 0u, 0u, 0u};
    if (tid < 64) nvec[tid] = 0.f;
    LAS float* cw = (LAS float*)(lds + M_CW); LAS float* mlgl = (LAS float*)(lds + M_MLG);
    for (int i = tid; i < 640; i += 512) { const int j = i >> 7, ch = i & 127, gch = (ch >> 6) * 512 + hd * 64 + (ch & 63); cw[i] = (j < 4) ? conv_w[j * 1024 + gch] : conv_b[gch]; }
    if (tid < 128) mlgl[tid] = mlg[hd * 128 + tid];
    __syncthreads();
    v4u qk[5], vv[2]; float pli = 0.f, plf = 0.f;
#define ML_LOAD(c_) do { const int t0_ = 64 * (c_); \
        { _Pragma("unroll") for (int i = 0; i < 5; ++i) { const int t_ = t0_ + 2 * rg - 3 + i; \
            qk[i] = (t_ >= 0) ? *(const v4u*)(P + pidx(rowb + t_, 4608 + chb)) : (v4u){0u, 0u, 0u, 0u}; } } \
        _Pragma("unroll") for (int i = 0; i < 2; ++i) { const int idx_ = tid + 512 * i, s_ = idx_ >> 4, ch_ = idx_ & 15; \
            vv[i] = *(const v4u*)(P + pidx(rowb + t0_ + s_, 5632 + hd * 128 + 8 * ch_)); } \
        if (wv == 0) { const size_t r_ = (rowb + t0_ + lane) * 16; pli = IFg[r_ + hd]; plf = IFg[r_ + 8 + hd]; } } while (0)
#define ML_WRITE() do { \
        { float wj[4][8], bs[8]; \
            _Pragma("unroll") for (int j = 0; j < 4; ++j) { const f32x4 a_ = *(const LAS f32x4*)(cw + j * 128 + lch), b_ = *(const LAS f32x4*)(cw + j * 128 + lch + 4); \
                wj[j][0] = a_[0]; wj[j][1] = a_[1]; wj[j][2] = a_[2]; wj[j][3] = a_[3]; wj[j][4] = b_[0]; wj[j][5] = b_[1]; wj[j][6] = b_[2]; wj[j][7] = b_[3]; } \
            { const f32x4 a_ = *(const LAS f32x4*)(cw + 512 + lch), b_ = *(const LAS f32x4*)(cw + 512 + lch + 4); bs[0] = a_[0]; bs[1] = a_[1]; bs[2] = a_[2]; bs[3] = a_[3]; bs[4] = b_[0]; bs[5] = b_[1]; bs[6] = b_[2]; bs[7] = b_[3]; } \
            _Pragma("unroll") for (int rr = 0; rr < 2; ++rr) { float y_[8]; \
                _Pragma("unroll") for (int e = 0; e < 8; ++e) y_[e] = bs[e]; \
                _Pragma("unroll") for (int j = 0; j < 4; ++j) { const v4u x_ = *(const LAS v4u*)(slot + (rr + j) * 8192); \
                    y_[0] += wj[j][0] * lo_f(x_.x); y_[1] += wj[j][1] * hi_f(x_.x); y_[2] += wj[j][2] * lo_f(x_.y); y_[3] += wj[j][3] * hi_f(x_.y); \
                    y_[4] += wj[j][4] * lo_f(x_.z); y_[5] += wj[j][5] * hi_f(x_.z); y_[6] += wj[j][6] * lo_f(x_.w); y_[7] += wj[j][7] * hi_f(x_.w); } \
                _Pragma("unroll") for (int e = 0; e < 8; ++e) { y_[e] = y_[e] * sigmoidf_(y_[e]); if (isk) y_[e] *= 0.125f; } \
                v4u o_; o_.x = pk2(y_[0], y_[1]); o_.y = pk2(y_[2], y_[3]); o_.z = pk2(y_[4], y_[5]); o_.w = pk2(y_[6], y_[7]); \
                const int s_ = 2 * rg + rr; \
                if (!isk) *(LAS v4u*)(Qt + s_ * 144 + 16 * cgp) = o_; else { *(LAS v4u*)(Kt + s_ * 144 + 16 * cgp) = o_; *(LAS v4u*)(Kt2 + s_ * 192 + 16 * cgp) = o_; } } } \
        _Pragma("unroll") for (int i = 0; i < 2; ++i) { const int idx_ = tid + 512 * i, s_ = idx_ >> 4, ch_ = idx_ & 15; *(LAS v4u*)(Vt + s_ * 320 + 16 * ch_) = *(const LAS v4u*)(slot + (5 + i) * 8192); } \
        ML_GSTORE(); } while (0)
#define ML_GCOMP() do { if (wv == 0) { float b_ = plf2; \
            _Pragma("unroll") for (int o = 1; o < 64; o <<= 1) { const float v_ = __shfl_up(b_, o); if (lane >= o) b_ += v_; } \
            const float d_ = pli2 - b_; float cm_ = d_; \
            _Pragma("unroll") for (int o = 1; o < 64; o <<= 1) { const float v_ = __shfl_up(cm_, o); if (lane >= o) cm_ = fmaxf(cm_, v_); } \
            const float M_ = fmaxf(m_run, cm_); const float bend_ = __shfl(b_, 63), M63_ = __shfl(M_, 63); \
            g_d = d_ * 1.4426950408889634f; g_M = M_ * 1.4426950408889634f; g_i = __expf(m_run - M_); g_e = __expf(-(b_ + M_)); g_w = __expf(d_ - M63_); g_dec = __expf(m_run - M63_); \
            m_run = bend_ + M63_; } } while (0)
#define ML_GSTORE() do { if (wv == 0) { gate[lane] = g_d; gate[64 + lane] = g_M; gate[128 + lane] = g_i; gate[192 + lane] = g_e; gate[256 + lane] = g_w; if (lane == 0) gate[320] = g_dec; } } while (0)
    float g_d = 0.f, g_M = 0.f, g_i = 0.f, g_e = 0.f, g_w = 0.f, g_dec = 0.f;

    LAS unsigned char* slot = lds + M_SLOT + tid * 16; float pli2 = 0.f, plf2 = 0.f;
#define ML_PARK() do { _Pragma("unroll") for (int i = 0; i < 5; ++i) *(LAS v4u*)(slot + i * 8192) = qk[i]; *(LAS v4u*)(slot + 5 * 8192) = vv[0]; *(LAS v4u*)(slot + 6 * 8192) = vv[1]; pli2 = pli; plf2 = plf; } while (0)
    ML_LOAD(0);
    ML_PARK();
    ML_GCOMP();
    ML_WRITE();
    ML_LOAD(1);
    for (int c = 0; c < 32; ++c) {
        __syncthreads();
        if (c < 31) ML_PARK();
        if (c < 30) ML_LOAD(c + 2);
        if (c < 31) ML_GCOMP();
        const int t = 32 * th + r32; const size_t row = rowb + 64 * c + t;
        v2u og[4];
#pragma unroll
        for (int rq = 0; rq < 4; ++rq) og[rq] = *(const v2u*)(P + pidx(row, 6656 + hd * 128 + 32 * dvs + 8 * rq + 4 * hh));
        const float Mt = gate[64 + t], it = gate[128 + t], et = gate[192 + t], dec = gate[320];
        bf16x8 qf[4];
#pragma unroll
        for (int kk = 0; kk < 4; ++kk) qf[kk] = *(const LAS bf16x8*)(Qt + t * 144 + 32 * kk + 16 * hh);
        f32x16 sacc[2];
#pragma unroll
        for (int st = 0; st < 2; ++st) {
#pragma unroll
            for (int i = 0; i < 16; ++i) sacc[st][i] = 0.f;
            if (st <= th) {
#pragma unroll
                for (int kk = 0; kk < 4; ++kk) { const bf16x8 a = *(const LAS bf16x8*)(Kt + (32 * st + r32) * 144 + 32 * kk + 16 * hh); sacc[st] = MFMA32(a, qf[kk], sacc[st]); } }
        }
        float rowsum = 0.f; bf16x8 Wf[4];
#pragma unroll
        for (int st = 0; st < 2; ++st) {
            if (st <= th) {
#pragma unroll
            for (int rq = 0; rq < 4; ++rq) { const f32x4 d4 = *(const LAS f32x4*)(gate + 32 * st + 8 * rq + 4 * hh);
#pragma unroll
                for (int i = 0; i < 4; ++i) { const int s = 32 * st + 8 * rq + 4 * hh + i; const float e = __builtin_amdgcn_exp2f(d4[i] - Mt); const float w = (s <= t) ? sacc[st][4 * rq + i] * e : 0.f; rowsum += w; sacc[st][4 * rq + i] = w; } } }
            Wf[2 * st] = pack8(sacc[st][0], sacc[st][1], sacc[st][2], sacc[st][3], sacc[st][4], sacc[st][5], sacc[st][6], sacc[st][7]);
            Wf[2 * st + 1] = pack8(sacc[st][8], sacc[st][9], sacc[st][10], sacc[st][11], sacc[st][12], sacc[st][13], sacc[st][14], sacc[st][15]);
        }
        float qn = 0.f;
#pragma unroll
        for (int kk = 0; kk < 4; ++kk) { const f32x4 n0 = *(const LAS f32x4*)(nvec + 16 * kk + 8 * hh), n1 = *(const LAS f32x4*)(nvec + 16 * kk + 8 * hh + 4); const v4u q = __builtin_bit_cast(v4u, qf[kk]);
            qn += lo_f(q.x) * n0[0] + hi_f(q.x) * n0[1] + lo_f(q.y) * n0[2] + hi_f(q.y) * n0[3] + lo_f(q.z) * n1[0] + hi_f(q.z) * n1[1] + lo_f(q.w) * n1[2] + hi_f(q.w) * n1[3]; }
        qn += __shfl_xor(qn, 32); rowsum += __shfl_xor(rowsum, 32);
        const float nq = rowsum + it * qn; const float invd = 1.0f / fmaxf(fabsf(nq), et);
        bf16x8 vf[4];
#pragma unroll
        for (int k4 = 0; k4 < 4; ++k4) { LAS unsigned char* p = Vt + (16 * k4 + 4 * hh + q4) * 320 + 2 * (32 * dvs + 16 * gg + 4 * p4); vf[k4] = tr8(p, p + 8 * 320); }
        f32x16 num, qc;
#pragma unroll
        for (int i = 0; i < 16; ++i) { num[i] = 0.f; qc[i] = 0.f; }
#pragma unroll
        for (int k4 = 0; k4 < 4; ++k4) if (k4 < 2 * (th + 1)) num = MFMA32(vf[k4], Wf[k4], num);
#pragma unroll
        for (int kk = 0; kk < 4; ++kk) { LAS unsigned char* p = Cimg + (16 * kk + 8 * hh + q4) * 320 + 2 * (32 * dvs + 16 * gg + 4 * p4); const bf16x8 cf = tr8(p, p + 4 * 320); qc = MFMA32(cf, qf[kk], qc); }
        float hv[16]; float ss = 0.f;
#pragma unroll
        for (int i = 0; i < 16; ++i) { hv[i] = (num[i] + it * qc[i]) * invd; ss += hv[i] * hv[i]; }
        ss += __shfl_xor(ss, 32);
        if (hh == 0) ssq[dvs * 64 + t] = ss;
#pragma unroll
        for (int i = 0; i < 16; ++i) Cst[i] *= dec;
#pragma unroll
        for (int k4 = 0; k4 < 4; ++k4) { const f32x4 wa = *(const LAS f32x4*)(gate + 256 + 16 * k4 + 4 * hh), wb = *(const LAS f32x4*)(gate + 256 + 16 * k4 + 8 + 4 * hh);
            LAS unsigned char* p = Kt2 + (16 * k4 + 4 * hh + q4) * 192 + 2 * (32 * th + 16 * gg + 4 * p4); const v4u kq = __builtin_bit_cast(v4u, tr8(p, p + 8 * 192));
            const bf16x8 kf2 = pack8(lo_f(kq.x) * wa[0], hi_f(kq.x) * wa[1], lo_f(kq.y) * wa[2], hi_f(kq.y) * wa[3], lo_f(kq.z) * wb[0], hi_f(kq.z) * wb[1], lo_f(kq.w) * wb[2], hi_f(kq.w) * wb[3]);
            Cst = MFMA32(vf[k4], kf2, Cst); }
        { float np = 0.f;
#pragma unroll
            for (int i = 0; i < 8; ++i) { const int s = 8 * wv + i; np += gate[256 + s] * bf2f(*(const LAS unsigned short*)(Kt + s * 144 + 2 * lane)); }
            npart[wv * 64 + lane] = np; }
        __syncthreads();
        const float tot = ssq[t] + ssq[64 + t] + ssq[128 + t] + ssq[192 + t]; const float rstd = rsqrtf(tot * (1.0f / 128.0f) + 1e-6f);
#pragma unroll
        for (int rq = 0; rq < 4; ++rq) { const int dv = 32 * dvs + 8 * rq + 4 * hh; const f32x4 gl = *(const LAS f32x4*)(mlgl + dv);
            const float o0 = hv[4 * rq] * rstd * gl[0] * lo_f(og[rq].x), o1 = hv[4 * rq + 1] * rstd * gl[1] * hi_f(og[rq].x), o2 = hv[4 * rq + 2] * rstd * gl[2] * lo_f(og[rq].y), o3 = hv[4 * rq + 3] * rstd * gl[3] * hi_f(og[rq].y);
            v2u w; w.x = pk2(o0, o1); w.y = pk2(o2, o3); *(v2u*)(Hout + row * 1024 + hd * 128 + dv) = w;
            v2u cw; cw.x = pk2(Cst[4 * rq], Cst[4 * rq + 1]); cw.y = pk2(Cst[4 * rq + 2], Cst[4 * rq + 3]);
            *(LAS v2u*)(Cimg + (32 * th + r32) * 320 + 2 * dv) = cw; }
        if (wv == 5) { float s = 0.f;
#pragma unroll
            for (int w = 0; w < 8; ++w) s += npart[w * 64 + lane];
            n_reg = dec * n_reg + s; nvec[lane] = n_reg; }
        if (c < 31) ML_WRITE();
    }
#undef ML_LOAD
#undef ML_PARK
#undef ML_GCOMP
#undef ML_GSTORE
#undef ML_WRITE
    __syncthreads();
}

constexpr int A_HALF = 39168, A_K = 0, A_V = 17408, A_BIAS = 37888, A_GQ = 78336, A_GK = 78848, A_UNIT = 79360;
DI void attn_unit(LAS unsigned char* lds, const bf16* P, bf16* OG, float* LSE, const float* relb, int u) {
    int tid_ = threadIdx.x; asm volatile("" : "+v"(tid_));
    const int tid = tid_, hw = __builtin_amdgcn_readfirstlane(tid >> 8), htid = tid & 255, w = __builtin_amdgcn_readfirstlane((tid >> 6) & 3), lane = tid & 63, r32 = lane & 31, hh = lane >> 5;
    const int i16 = lane & 15, q4 = i16 >> 2, p4 = i16 & 3, gg = (lane >> 4) & 1;
    const int bp = u & 7, t2 = u >> 3, head = t2 % 12, bl = t2 / 12, g = head >> 2, hs = head & 3;
    const int dil = (g == 0) ? 1 : ((g == 1) ? 4 : 16), nbs = (g == 0) ? 4 : ((g == 1) ? 2 : 0);
    const int blk = 2 * bp + hw, r = blk >> nbs, qb = blk & ((1 << nbs) - 1);
    const size_t rowb = (size_t)bl * 2048;
    LAS unsigned char* Kl = lds + hw * A_HALF + A_K; LAS unsigned char* Vl = lds + hw * A_HALF + A_V; LAS float* biasT = (LAS float*)(lds + hw * A_HALF + A_BIAS);
    const LAS float* gq = (const LAS float*)(lds + A_GQ);
#pragma unroll
    for (int jj = 0; jj < 2; ++jj) { const int j = htid + 256 * jj;
        if (j < 320) { const int delta = j - 96; float val = -1e30f;
            if (delta >= 0 && delta <= 128) { const int dist = delta * dil; int bucket;
                if (dist < 16) bucket = dist; else { const float d = (float)dist; int lg = 16 + (int)(logf(d / 16.0f) / logf(128.0f) * 16.0f); bucket = lg < 31 ? lg : 31; }
                val = relb[bucket * 12 + head] * 1.4426950408889634f; }
            biasT[j] = val; } }
    const int kr = htid >> 2, qt = htid & 3;
    v4u kreg[4], vreg[4];
#define AT_LOAD(t_) do { const int ks0_ = 128 * (qb - 1) + 64 * (t_); if (ks0_ >= 0) { const size_t ktok_ = rowb + (size_t)(ks0_ + kr) * dil + r; const bf16* kp_ = P + pidx(ktok_, 1536 + head * 128 + qt * 32); \
        _Pragma("unroll") for (int i = 0; i < 4; ++i) { kreg[i] = *(const v4u*)(kp_ + 8 * i); vreg[i] = *(const v4u*)(kp_ + (size_t)6 * TH * 256 + 8 * i); } } } while (0)
    const int tstart = (g == 2) ? 2 : 0;
    AT_LOAD(tstart);
    const int qmin = 128 * qb + 32 * w, qsub = qmin + r32; const size_t qtok = rowb + (size_t)qsub * dil + r;
    bf16x8 qf[8];
    { const bf16* qrow = P + pidx(qtok, head * 128); v4u qraw[8]; float ss = 0.f;
#pragma unroll
        for (int kk = 0; kk < 8; ++kk) { qraw[kk] = *(const v4u*)(qrow + 16 * kk + 8 * hh); const v4u q = qraw[kk];
            ss += lo_f(q.x) * lo_f(q.x) + hi_f(q.x) * hi_f(q.x) + lo_f(q.y) * lo_f(q.y) + hi_f(q.y) * hi_f(q.y) + lo_f(q.z) * lo_f(q.z) + hi_f(q.z) * hi_f(q.z) + lo_f(q.w) * lo_f(q.w) + hi_f(q.w) * hi_f(q.w); }
        ss += __shfl_xor(ss, 32);
        const float rs = rsqrtf(ss * (1.0f / 128.0f) + 1e-6f) * (0.08838834764831845f * 1.4426950408889634f);
#pragma unroll
        for (int kk = 0; kk < 8; ++kk) { const v4u q = qraw[kk]; const f32x4 g0 = *(const LAS f32x4*)(gq + 16 * kk + 8 * hh), g1 = *(const LAS f32x4*)(gq + 16 * kk + 8 * hh + 4);
            qf[kk] = pack8(lo_f(q.x) * rs * g0[0], hi_f(q.x) * rs * g0[1], lo_f(q.y) * rs * g0[2], hi_f(q.y) * rs * g0[3], lo_f(q.z) * rs * g1[0], hi_f(q.z) * rs * g1[1], lo_f(q.w) * rs * g1[2], hi_f(q.w) * rs * g1[3]); }
    }
    f32x16 O[4];
#pragma unroll
    for (int dt = 0; dt < 4; ++dt)
#pragma unroll
        for (int i = 0; i < 16; ++i) O[dt][i] = 0.f;
    float m = -1e30f, l = 0.f;
    for (int t = tstart; t < 4; ++t) {
        const int ks0 = 128 * (qb - 1) + 64 * t; const bool tvalid = ks0 >= 0;
        __syncthreads();
        if (tvalid) {
            float ss = 0.f;
#pragma unroll
            for (int i = 0; i < 4; ++i) { const v4u q = kreg[i];
                ss += lo_f(q.x) * lo_f(q.x) + hi_f(q.x) * hi_f(q.x) + lo_f(q.y) * lo_f(q.y) + hi_f(q.y) * hi_f(q.y) + lo_f(q.z) * lo_f(q.z) + hi_f(q.z) * hi_f(q.z) + lo_f(q.w) * lo_f(q.w) + hi_f(q.w) * hi_f(q.w); }
            ss += __shfl_xor(ss, 1); ss += __shfl_xor(ss, 2);
            const float rs = rsqrtf(ss * (1.0f / 128.0f) + 1e-6f);
#pragma unroll
            for (int i = 0; i < 4; ++i) { const v4u q = kreg[i];
                v4u o; o.x = pk2(lo_f(q.x) * rs, hi_f(q.x) * rs); o.y = pk2(lo_f(q.y) * rs, hi_f(q.y) * rs); o.z = pk2(lo_f(q.z) * rs, hi_f(q.z) * rs); o.w = pk2(lo_f(q.w) * rs, hi_f(q.w) * rs);
                *(LAS v4u*)(Kl + kr * 272 + qt * 64 + 16 * i) = o; *(LAS v4u*)(Vl + kr * 320 + qt * 64 + 16 * i) = vreg[i]; }
        }
        __syncthreads();
        if (t < 3) AT_LOAD(t + 1);
        const bool active = tvalid && (qmin + 31 - ks0 >= 0) && (qmin - (ks0 + 63) <= 128);
        if (active) {
            f32x16 p0, p1;
#pragma unroll
            for (int i = 0; i < 16; ++i) { p0[i] = 0.f; p1[i] = 0.f; }
#pragma unroll
            for (int kk = 0; kk < 8; ++kk) { const bf16x8 a0 = *(const LAS bf16x8*)(Kl + r32 * 272 + 32 * kk + 16 * hh), a1 = *(const LAS bf16x8*)(Kl + (32 + r32) * 272 + 32 * kk + 16 * hh);
                p0 = MFMA32(a0, qf[kk], p0); p1 = MFMA32(a1, qf[kk], p1); }
            float mx = -1e30f;
            {
                const LAS float* bp = biasT + (qsub - ks0 + 96 - 4 * hh - 63);
#pragma unroll
                for (int i = 0; i < 16; ++i) { const int ko = (i & 3) + 8 * (i >> 2);
                    p0[i] += bp[63 - ko]; p1[i] += bp[63 - 32 - ko]; mx = fmaxf(mx, fmaxf(p0[i], p1[i])); }
            }
            mx = fmaxf(mx, __shfl_xor(mx, 32));
            const float mnew = fmaxf(m, mx), alpha = __builtin_amdgcn_exp2f(m - mnew); m = mnew;
            float ls = 0.f;
#pragma unroll
            for (int i = 0; i < 16; ++i) { p0[i] = __builtin_amdgcn_exp2f(p0[i] - mnew); p1[i] = __builtin_amdgcn_exp2f(p1[i] - mnew); ls += p0[i] + p1[i]; }
            l = l * alpha + ls;
            if (__ballot(alpha != 1.0f) != 0ull) {
#pragma unroll
            for (int dt = 0; dt < 4; ++dt)
#pragma unroll
                for (int i = 0; i < 16; ++i) O[dt][i] *= alpha;
            }
#pragma unroll
            for (int k4 = 0; k4 < 4; ++k4) {
                bf16x8 pf;
                if (k4 == 0) pf = pack8(p0[0], p0[1], p0[2], p0[3], p0[4], p0[5], p0[6], p0[7]);
                else if (k4 == 1) pf = pack8(p0[8], p0[9], p0[10], p0[11], p0[12], p0[13], p0[14], p0[15]);
                else if (k4 == 2) pf = pack8(p1[0], p1[1], p1[2], p1[3], p1[4], p1[5], p1[6], p1[7]);
                else pf = pack8(p1[8], p1[9], p1[10], p1[11], p1[12], p1[13], p1[14], p1[15]);
#pragma unroll
                for (int dt = 0; dt < 4; ++dt) { LAS unsigned char* p = Vl + (16 * k4 + 4 * hh + q4) * 320 + 2 * (32 * dt + 16 * gg + 4 * p4); const bf16x8 va = tr8(p, p + 8 * 320); O[dt] = MFMA32(va, pf, O[dt]); }
            }
        }
    }
#undef AT_LOAD
    l += __shfl_xor(l, 32);
    const float inv = 1.0f / l;
    bf16* orow = OG + (size_t)g * ((size_t)TH * 512) + qtok * 512 + hs * 128;
#pragma unroll
    for (int dt = 0; dt < 4; ++dt)
#pragma unroll
        for (int rq = 0; rq < 4; ++rq) { v2u wv; wv.x = pk2(O[dt][4 * rq] * inv, O[dt][4 * rq + 1] * inv); wv.y = pk2(O[dt][4 * rq + 2] * inv, O[dt][4 * rq + 3] * inv);
            *(v2u*)(orow + 32 * dt + 8 * rq + 4 * hh) = wv; }
    if (hh == 0) LSE[qtok * 12 + head] = m * 0.6931471805599453f + __logf(l);
}

#define XB_TMO      128
#define XB_XCNT(j)  (256  + 64 * (j))
#define XB_XSUB(j)  (1280 + 64 * (j))
#define XB_XGEN(j)  (2304 + 64 * (j))
#define XB_TOP      3328
#define XB_TOPGEN   3392
#define XCD_BAR_WORDS 3456
#define XB_SPIN_CAP (1u << 18)

__device__ __forceinline__ unsigned xb_ld(unsigned* p)              { return __hip_atomic_load(p, __ATOMIC_RELAXED, __HIP_MEMORY_SCOPE_AGENT); }
__device__ __forceinline__ unsigned xb_add(unsigned* p, unsigned v) { return __hip_atomic_fetch_add(p, v, __ATOMIC_RELAXED, __HIP_MEMORY_SCOPE_AGENT); }
__device__ __forceinline__ unsigned xb_xcc_id() { return (unsigned)__builtin_amdgcn_s_getreg((3 << 11) | 20) & 0xFu; }
#define XB_SPIN(cond, bar) do { unsigned _sp = 0; while (cond) { __builtin_amdgcn_s_sleep(1); \
    if ((++_sp & 255u) == 0u) { if (xb_ld(&(bar)[XB_TMO])) break; if (_sp > XB_SPIN_CAP) { atomicAdd(&(bar)[XB_TMO], 1u); break; } } } } while (0)

struct XcdBarrier {
    unsigned* bar; unsigned x;
    volatile LAS unsigned* st;
};

__device__ __forceinline__ XcdBarrier xcd_barrier_post(unsigned* bar, volatile LAS unsigned* st) {
    XcdBarrier b; b.bar = bar; b.x = xb_xcc_id(); b.st = st;
    if (threadIdx.x == 0) (void)xb_add(&bar[XB_XCNT(b.x)], 1u);
    return b;
}
__device__ __forceinline__ void xcd_barrier_complete(unsigned* bar, unsigned x, unsigned& nloc, unsigned& nx) {
    const unsigned G = gridDim.x * gridDim.y * gridDim.z;
    unsigned sum, cnt, mine, sp = 0u;
    for (;;) {
        sum = 0u; cnt = 0u; mine = 0u;
#pragma unroll
        for (unsigned j = 0; j < 16; ++j) { const unsigned c = xb_ld(&bar[XB_XCNT(j)]); sum += c; cnt += (c > 0u) ? 1u : 0u; mine = (j == x) ? c : mine; }
        if (sum == G) break;
        __builtin_amdgcn_s_sleep(1);
        if ((++sp & 255u) == 0u) { if (xb_ld(&bar[XB_TMO])) break; if (sp > XB_SPIN_CAP) { atomicAdd(&bar[XB_TMO], 1u); break; } }
    }
    nloc = mine > 0u ? mine : 1u; nx = cnt > 0u ? cnt : 1u;
}

__device__ __forceinline__ void xcd_barrier(const XcdBarrier& b) {
    asm volatile("s_waitcnt vmcnt(0)" ::: "memory");
    __syncthreads();
    if (threadIdx.x == 0) {
        unsigned* bar = b.bar;
        __builtin_amdgcn_s_waitcnt(0);
        unsigned nloc = b.st[0], nx = b.st[1];
        if (nloc == 0u) { xcd_barrier_complete(bar, b.x, nloc, nx); b.st[0] = nloc; b.st[1] = nx; }
        const unsigned old = xb_add(&bar[XB_XSUB(b.x)], 1u);
        const unsigned gen = old / nloc;
        if (old + 1u == (gen + 1u) * nloc) {
            __builtin_amdgcn_fence(__ATOMIC_RELEASE, "agent");
            asm volatile("s_waitcnt vmcnt(0)" ::: "memory");
            const unsigned og = xb_add(&bar[XB_TOP], 1u);
            const unsigned tg = og / nx;
            if (og + 1u == (tg + 1u) * nx) xb_add(&bar[XB_TOPGEN], 1u);
            else XB_SPIN(xb_ld(&bar[XB_TOPGEN]) == tg, bar);
            __builtin_amdgcn_fence(__ATOMIC_ACQUIRE, "agent");
            xb_add(&bar[XB_XGEN(b.x)], 1u);
            asm volatile("s_waitcnt vmcnt(0)" ::: "memory");
        } else {
            XB_SPIN(xb_ld(&bar[XB_XGEN(b.x)]) == gen, bar);
            __builtin_amdgcn_fence(__ATOMIC_ACQUIRE, "agent");
            asm volatile("s_waitcnt vmcnt(0)" ::: "memory");
        }
    }
    __syncthreads();
}

#ifndef REP_G1
#define REP_G1 1
#endif
#ifndef REP_ML
#define REP_ML 1
#endif
#ifndef REP_ATT
#define REP_ATT 1
#endif
#ifndef REP_MIX
#define REP_MIX 1
#endif
#ifndef REP_FFN
#define REP_FFN 1
#endif
struct Args { const float* in[19]; float* out; unsigned char* ws; };

__global__ void __launch_bounds__(512, 2) fwd_mega(Args a) {
    extern __shared__ __attribute__((aligned(16))) unsigned char lds_raw[];
    LAS unsigned char* lds = (LAS unsigned char*)lds_raw;
    cg::grid_group grid = cg::this_grid();
#define FRESH_IDS() int tid = threadIdx.x; asm volatile("" : "+v"(tid)); const int lane = tid & 63, wave = __builtin_amdgcn_readfirstlane(tid >> 6), gw = bx * 8 + wave; (void)lane; (void)gw
    const int G = gridDim.x, bx = blockIdx.x, ngw = G * 8;
    unsigned char* ws = a.ws;
    float* ada = (float*)(ws + WS_ADA); unsigned* ctl = (unsigned*)(ws + WS_CTL); float* rowss = (float*)(ws + WS_ROWSS); float* bias2 = (float*)(ws + WS_BIAS2);
    bf16* WinT = (bf16*)(ws + WS_WIN); bf16* WattT = (bf16*)(ws + WS_WATT); bf16* WmlT = (bf16*)(ws + WS_WML); bf16* WoutT = (bf16*)(ws + WS_WOUT); bf16* Wff1T = (bf16*)(ws + WS_WFF1); bf16* Wff2T = (bf16*)(ws + WS_WFF2);
    float* IFg = (float*)(ws + WS_IF); bf16* U = (bf16*)(ws + WS_U); bf16* P = (bf16*)(ws + WS_P); bf16* HID = (bf16*)(ws + WS_HID); bf16* OG = (bf16*)(ws + WS_OG); bf16* YPRE = (bf16*)(ws + WS_YPRE);
    float* LSE = (float*)(ws + WS_LSE); bf16* Hb = (bf16*)(ws + WS_H); bf16* ATT = (bf16*)(ws + WS_ATT);
    const float* x = a.in[0]; float* out = a.out;
    volatile LAS unsigned* bst = (volatile LAS unsigned*)(lds + LDS_BYTES - 16);
    if (threadIdx.x == 0) { bst[0] = 0u; bst[1] = 0u; }
    __syncthreads();
    (void)xcd_barrier_post(ctl + 4096, bst);
#define GBAR() do { XcdBarrier xb_; xb_.bar = (unsigned*)(a.ws + WS_CTL) + 4096; xb_.x = xb_xcc_id(); xb_.st = (volatile LAS unsigned*)(lds + LDS_BYTES - 16); xcd_barrier(xb_); } while (0)

    {
        FRESH_IDS();
        LAS float* scr = (LAS float*)(lds + wave * 16384);
        constexpr int I0 = 3840, I1 = 1024, I2 = 16, I3 = 256, I4 = 512, I5 = 512, I6 = 2048, I7 = 2048, I8 = 768;
        constexpr int NIT = I0 + I1 + I2 + I3 + I4 + I5 + I6 + I7 + I8;
        for (int it = gw; it < NIT; it += ngw) {
            int r = it;
            if (r < I8) { ada_item(a.in[1], a.in[2], a.in[3], ada, scr, r, lane); continue; } r -= I8;
            if (r < I0) { wseg(a.in[6], DIN, 1024, 240, 0, 0, WinT, scr, r, lane); continue; } r -= I0;
            if (r < I1) { wseg(a.in[6], DIN, 1024, 64, 7696, 7680, WinT, scr, r, lane); continue; } r -= I1;
            if (r < I2) { wseg(a.in[6], DIN, 1024, 1, 7680, 9728, WinT, scr, r, lane); continue; } r -= I2;
            if (r < I3) { wseg(a.in[14], 1024, 512, 32, 0, 0, WattT, scr, r, lane); continue; } r -= I3;
            if (r < I4) { wseg(a.in[15], 1024, 1024, 32, 0, 0, WmlT, scr, r, lane); continue; } r -= I4;
            if (r < I5) { wseg(a.in[16], 1024, 1024, 32, 0, 0, WoutT, scr, r, lane); continue; } r -= I5;
            if (r < I6) { wseg(a.in[17], 4096, 1024, 128, 0, 0, Wff1T, scr, r, lane); continue; } r -= I6;
            wseg(a.in[18], 1024, 4096, 32, 0, 0, Wff2T, scr, r, lane);
        }
    }
    grid.sync();
    { FRESH_IDS(); LAS float* scr = (LAS float*)(lds + wave * 16384);
      for (int it = gw; it < 512; it += ngw) bias2_item(ada, a.in[17], bias2, scr, it, lane);
      prenorm_rows(x, a.in[4], ada, 0, 1024, U, 0, T_ALL, gw, ngw, lane); }
    GBAR();

    for (int hb = 0; hb < 2; ++hb) {
        const int grow0 = hb * TH;
        for (int rep = 0; rep < REP_G1; ++rep) {
        { pg8::Gemm g{U + (size_t)grow0 * 1024, WinT, TH, 38 * 256, 1024}; pg8::StaticOrder S; S.init(TH, 38 * 256, G, bx);
          EpiInProj E{P, IFg + (size_t)grow0 * 16, a.in[7]};
          pg8::gemm_phase<EpiInProj, pg8::StaticOrder, true, true>(lds, g, S, E); }
        __syncthreads();
        { pg8::Gemm g{U + (size_t)grow0 * 1024, WinT + (size_t)38 * 256 * 1024, TH, 256, 1024}; pg8::StaticOrder S; S.init(TH, 256, G, bx);
          EpiIF E{IFg + (size_t)grow0 * 16, a.in[7]};
          pg8::gemm_phase<EpiIF, pg8::StaticOrder, true, true>(lds, g, S, E); }
        }
        GBAR();
        for (int rep = 0; rep < REP_MIX; ++rep)
        {
            FRESH_IDS();
            for (int r2 = 0; r2 < REP_ML; ++r2) for (int seq = bx; seq < 128; seq += G) mlstm_seq(lds, P, IFg + (size_t)grow0 * 16, Hb, a.in[8], a.in[9], a.in[13], seq);
            if (tid < 128) ((LAS float*)(lds + A_GQ))[tid] = a.in[10][tid] * a.in[11][tid];
            LAS int* s_unit = (LAS int*)(lds + A_UNIT);
            for (int r3 = 0; r3 < REP_ATT; ++r3) {
                unsigned* ctr = ctl + 64 * hb + 128 * rep + 256 * r3;
                __syncthreads();
                if (tid == 0) s_unit[0] = (int)atomicAdd(ctr, 1u);
                __syncthreads();
                int u = s_unit[0], par = 0;
                while (u < 1536) {
                    int nxt = 0;
                    if (tid == 0) nxt = (int)atomicAdd(ctr, 1u);
                    attn_unit(lds, P, OG, LSE, a.in[12], u);
                    if (tid == 0) s_unit[par ^ 1] = nxt;
                    __syncthreads();
                    par ^= 1; u = s_unit[par];
                }
            }
        }
        GBAR();
        { FRESH_IDS();
        for (int i = bx * 512 + tid; i < TH * 64; i += G * 512) {
            const int tok = i >> 6, rem = i & 63, hs = rem >> 4, ch = rem & 15;
            const float l0 = LSE[tok * 12 + hs], l1 = LSE[tok * 12 + 4 + hs], l2 = LSE[tok * 12 + 8 + hs];
            const float mx = fmaxf(l0, fmaxf(l1, l2)); float w0 = __expf(l0 - mx), w1 = __expf(l1 - mx), w2 = __expf(l2 - mx); const float inv = 1.0f / (w0 + w1 + w2); w0 *= inv; w1 *= inv; w2 *= inv;
            const size_t off = (size_t)tok * 512 + hs * 128 + ch * 8;
            const v4u o0 = *(const v4u*)(OG + off), o1 = *(const v4u*)(OG + (size_t)TH * 512 + off), o2 = *(const v4u*)(OG + (size_t)2 * TH * 512 + off);
            v4u r;
            r.x = pk2(w0 * lo_f(o0.x) + w1 * lo_f(o1.x) + w2 * lo_f(o2.x), w0 * hi_f(o0.x) + w1 * hi_f(o1.x) + w2 * hi_f(o2.x));
            r.y = pk2(w0 * lo_f(o0.y) + w1 * lo_f(o1.y) + w2 * lo_f(o2.y), w0 * hi_f(o0.y) + w1 * hi_f(o1.y) + w2 * hi_f(o2.y));
            r.z = pk2(w0 * lo_f(o0.z) + w1 * lo_f(o1.z) + w2 * lo_f(o2.z), w0 * hi_f(o0.z) + w1 * hi_f(o1.z) + w2 * hi_f(o2.z));
            r.w = pk2(w0 * lo_f(o0.w) + w1 * lo_f(o1.w) + w2 * lo_f(o2.w), w0 * hi_f(o0.w) + w1 * hi_f(o1.w) + w2 * hi_f(o2.w));
            *(v4u*)(ATT + off) = r;
        } }
        GBAR();
        { pg8::Gemm g{ATT, WattT, TH, 1024, 512}; pg8::StaticOrder S; S.init(TH, 1024, G, bx);
          EpiY1 E{P, YPRE};
          pg8::gemm_phase<EpiY1, pg8::StaticOrder, true, true>(lds, g, S, E); }
        __syncthreads();
        { pg8::Gemm g{Hb, WmlT, TH, 1024, 1024}; pg8::StaticOrder S; S.init(TH, 1024, G, bx);
          EpiYpre E{P, YPRE};
          pg8::gemm_phase<EpiYpre, pg8::StaticOrder, true, true>(lds, g, S, E); }
        GBAR();
        { pg8::Gemm g{YPRE, WoutT, TH, 1024, 1024}; pg8::StaticOrder S; S.init(TH, 1024, G, bx);
          EpiResidU2 E{x + (size_t)grow0 * 1024, out + (size_t)grow0 * 1024, ada, a.in[5], U + (size_t)grow0 * 1024, rowss + grow0, grow0};
          pg8::gemm_phase<EpiResidU2, pg8::StaticOrder, true, true>(lds, g, S, E); }
        GBAR();
        for (int rep = 0; rep < REP_FFN; ++rep)
        { pg8::Gemm g{U + (size_t)grow0 * 1024, Wff1T, TH, 4096, 1024}; pg8::StaticOrder S; S.init(TH, 4096, G, bx);
          EpiRelu2 E{HID, rowss + grow0, bias2, grow0};
          pg8::gemm_phase<EpiRelu2, pg8::StaticOrder, true, true>(lds, g, S, E); }
        GBAR();
        { pg8::Gemm g{HID, Wff2T, TH, 1024, 4096}; pg8::StaticOrder S; S.init(TH, 1024, G, bx);
          EpiResid E{out + (size_t)grow0 * 1024, out + (size_t)grow0 * 1024, ada + 5120, grow0};
          pg8::gemm_phase<EpiResid, pg8::StaticOrder, true, true>(lds, g, S, E); }
        if (hb == 0) GBAR();
    }
}

extern "C" void kernel_launch(void* const* d_in, const int* in_sizes, int n_in, void* d_out, int out_size, void* d_ws, size_t ws_size, hipStream_t stream) {
    static int grid = 0;
    if (grid == 0) {
        if (n_in != 19 || ws_size < WS_END) { fprintf(stderr, "kernel_launch: unexpected problem (n_in %d, ws %zu)\n", n_in, ws_size); grid = -1; return; }
        int dev = 0, cus = 0, per_cu = 0;
        hipGetDevice(&dev); hipDeviceGetAttribute(&cus, hipDeviceAttributeMultiprocessorCount, dev);
        if (hipFuncSetAttribute((const void*)fwd_mega, hipFuncAttributeMaxDynamicSharedMemorySize, LDS_BYTES) != hipSuccess) { fprintf(stderr, "kernel_launch: hipFuncSetAttribute failed\n"); grid = -1; return; }
        if (hipOccupancyMaxActiveBlocksPerMultiprocessor(&per_cu, (const void*)fwd_mega, 512, LDS_BYTES) != hipSuccess || per_cu < 1) { fprintf(stderr, "kernel_launch: occupancy query gave %d\n", per_cu); per_cu = 1; }
        (void)hipGetLastError();
        grid = cus * per_cu;
    }
    if (grid < 0) return;
    hipMemsetAsync((char*)d_ws + WS_ADA, 0, WS_ZERO_BYTES, stream);
    Args a{};
    for (int i = 0; i < 19; ++i) a.in[i] = (const float*)d_in[i];
    a.out = (float*)d_out; a.ws = (unsigned char*)d_ws;
    void* args[] = {&a};
    hipError_t e = hipLaunchCooperativeKernel((const void*)fwd_mega, dim3(grid), dim3(512), args, LDS_BYTES, stream);
    if (e != hipSuccess) fprintf(stderr, "cooperative launch failed: %s (grid %d)\n", hipGetErrorString(e), grid);
}
```
